# Optimizing an MI355X kernel written in HIP

```python
import jax, jax.numpy as jnp
from jax import lax
import numpy as np

D_MODEL = 1024
BATCH = 4
SEQ = 8192
DEPTH = 1

CTX_LEN = 256
GRID_W = 64
MIX_WIDTH = D_MODEL
FOURIER_WIDTH = MIX_WIDTH // 2
LRU_WIDTH = MIX_WIDTH // 2
FOURIER_HEADS = 8
FOURIER_HEAD_DIM = FOURIER_WIDTH // FOURIER_HEADS
LRU_HEADS = 8
LRU_HEAD_DIM = LRU_WIDTH // LRU_HEADS
IN_WIDTH = FOURIER_WIDTH + 2 * LRU_WIDTH
CONV_W = 4
LRU_C = 8.0
PEER_HEADS = 8
PEER_NKEYS = 128
PEER_EXPERTS = PEER_NKEYS * PEER_NKEYS
PEER_KEY_HALF = 128
PEER_TOPK = 16
PEER_CHUNK = 128
N_MOD = 6
EPS = 1e-6

kernel_name = 'hybrid_fnet_rglru_peer_block'


def rmsnorm(x, g):
    xf = x.astype(jnp.float32)
    y = xf * lax.rsqrt(jnp.mean(xf * xf, axis=-1, keepdims=True) + EPS)
    return (y * g.astype(jnp.float32)).astype(x.dtype)


def modulate(h, shift, scale):
    return h * (1 + scale) + shift


def dwconv(x, w, b):
    pad_l = CONV_W // 2
    pad_r = CONV_W - 1 - pad_l
    L = x.shape[-2]
    xp = jnp.pad(x, [(0, 0)] * (x.ndim - 2) + [(pad_l, pad_r), (0, 0)])
    y = b
    for k in range(CONV_W):
        y = y + xp[..., k:k + L, :] * w[k]
    return y


def fourier_mix(f):
    b_, L, _ = f.shape
    fh = f.astype(jnp.float32).reshape(b_, L, FOURIER_HEADS, FOURIER_HEAD_DIM)
    y = jnp.fft.fftn(fh, axes=(1, 3), norm='ortho').real
    return y.reshape(b_, L, FOURIER_WIDTH).astype(f.dtype)


def _lin_combine(left, right):
    a_l, b_l = left
    a_r, b_r = right
    return a_l * a_r, a_r * b_l + b_r


def rglru_scan(xc, w_a, b_a, w_x, b_x, lam, h0, reverse):
    b_, L, C = xc.shape
    xf = xc.astype(jnp.float32)
    xh = xf.reshape(b_, L, LRU_HEADS, LRU_HEAD_DIM)
    r = jax.nn.sigmoid(jnp.einsum('blhi,hij->blhj', xh, w_a.astype(jnp.float32)).reshape(b_, L, C) + b_a.astype(jnp.float32))
    i = jax.nn.sigmoid(jnp.einsum('blhi,hij->blhj', xh, w_x.astype(jnp.float32)).reshape(b_, L, C) + b_x.astype(jnp.float32))
    log_a = -LRU_C * r * jax.nn.softplus(-lam.astype(jnp.float32))
    a = jnp.exp(log_a)
    inp = jnp.sqrt(-jnp.expm1(2.0 * log_a)) * (i * xf)
    A, Bc = lax.associative_scan(_lin_combine, (a, inp), reverse=reverse, axis=1)
    h = A * h0[:, None, :] + Bc
    final = h[:, 0] if reverse else h[:, -1]
    return h, final


def peer_ffn(h, w_q, sub_keys, u_tab, v_tab):
    shp = h.shape
    flat = h.reshape(-1, PEER_CHUNK, shp[-1])

    def body(xc):
        T = xc.shape[0]
        q = (xc @ w_q).reshape(T, PEER_HEADS, 2, PEER_KEY_HALF)
        s = jnp.einsum('thpd,hpkd->thpk', q, sub_keys).astype(jnp.float32)
        s1, i1 = lax.top_k(s[:, :, 0], PEER_TOPK)
        s2, i2 = lax.top_k(s[:, :, 1], PEER_TOPK)
        cand = (s1[..., :, None] + s2[..., None, :]).reshape(T, PEER_HEADS, PEER_TOPK * PEER_TOPK)
        cidx = (i1[..., :, None] * PEER_NKEYS + i2[..., None, :]).reshape(T, PEER_HEADS, PEER_TOPK * PEER_TOPK)
        sc, pos = lax.top_k(cand, PEER_TOPK)
        idx = jnp.take_along_axis(cidx, pos, axis=-1)
        g = jax.nn.softmax(sc, axis=-1)
        u = u_tab[idx]
        act = jax.nn.gelu(jnp.einsum('thkd,td->thk', u, xc).astype(jnp.float32))
        return jnp.einsum('thk,thkd->td', (g * act).astype(xc.dtype), v_tab[idx])

    return lax.map(body, flat).reshape(shp)


def setup_inputs(seed: int = 0) -> dict:
    key = jax.random.key(seed)
    ks = jax.random.split(key, 24)
    D = D_MODEL

    def nrm(k, shape, scale):
        return jax.random.normal(k, shape, jnp.float32) * scale

    u = jax.random.uniform(ks[14], (DEPTH, 2, LRU_WIDTH), jnp.float32, minval=0.9, maxval=0.999)
    a0 = u ** (1.0 / LRU_C)
    return {
        'x': nrm(ks[0], (BATCH, SEQ, D), 1.0),
        'c': nrm(ks[1], (BATCH, D), 1.0),
        'ctx': nrm(ks[2], (BATCH, CTX_LEN, D), 1.0),
        'c_ctx': nrm(ks[3], (D,), 1.0),
        'w_mod': nrm(ks[4], (DEPTH, D, N_MOD * D), 0.5 * D ** -0.5),
        'b_mod': nrm(ks[5], (DEPTH, N_MOD * D), 0.02),
        'norm1_g': 1.0 + nrm(ks[6], (DEPTH, D), 0.02),
        'w_in': nrm(ks[7], (DEPTH, D, IN_WIDTH), D ** -0.5),
        'conv_w': nrm(ks[8], (DEPTH, CONV_W, LRU_WIDTH), CONV_W ** -0.5),
        'conv_b': nrm(ks[9], (DEPTH, LRU_WIDTH), 0.02),
        'lru_w_a': nrm(ks[10], (DEPTH, 2, LRU_HEADS, LRU_HEAD_DIM, LRU_HEAD_DIM), LRU_HEAD_DIM ** -0.5),
        'lru_b_a': nrm(ks[11], (DEPTH, 2, LRU_WIDTH), 0.02),
        'lru_w_x': nrm(ks[12], (DEPTH, 2, LRU_HEADS, LRU_HEAD_DIM, LRU_HEAD_DIM), LRU_HEAD_DIM ** -0.5),
        'lru_b_x': nrm(ks[13], (DEPTH, 2, LRU_WIDTH), 0.02),
        'lru_lambda': jnp.log(a0) - jnp.log1p(-a0),
        'fourier_out_g': 1.0 + nrm(ks[15], (DEPTH, FOURIER_WIDTH), 0.02),
        'lru_out_g': 1.0 + nrm(ks[16], (DEPTH, LRU_WIDTH), 0.02),
        'w_out': nrm(ks[17], (DEPTH, MIX_WIDTH, D), MIX_WIDTH ** -0.5),
        'norm2_g': 1.0 + nrm(ks[18], (DEPTH, D), 0.02),
        'peer_w_q': nrm(ks[19], (DEPTH, D, PEER_HEADS * 2 * PEER_KEY_HALF), D ** -0.5),
        'peer_sub_keys': nrm(ks[20], (DEPTH, PEER_HEADS, 2, PEER_NKEYS, PEER_KEY_HALF), PEER_KEY_HALF ** -0.5),
        'peer_u': nrm(ks[21], (DEPTH, PEER_EXPERTS, D), D ** -0.5),
        'peer_v': nrm(ks[22], (DEPTH, PEER_EXPERTS, D), PEER_HEADS ** -0.5),
        'final_norm_g': 1.0 + nrm(ks[23], (D,), 0.02),
    }


def reference(x, c, ctx, c_ctx, w_mod, b_mod, norm1_g, w_in, conv_w, conv_b, lru_w_a, lru_b_a,
              lru_w_x, lru_b_x, lru_lambda, fourier_out_g, lru_out_g, w_out, norm2_g,
              peer_w_q, peer_sub_keys, peer_u, peer_v, final_norm_g):
    B_, L, _ = x.shape
    ROWS = L // GRID_W
    C_LEN = ctx.shape[1]
    split_pts = [FOURIER_WIDTH, FOURIER_WIDTH + LRU_WIDTH]
    for l in range(DEPTH):
        update_ctx = l + 1 < DEPTH
        mod_x = jax.nn.silu(c) @ w_mod[l] + b_mod[l]
        mod_c = jax.nn.silu(c_ctx) @ w_mod[l] + b_mod[l]
        sh1_x, sc1_x, g1_x, sh2_x, sc2_x, g2_x = [m[:, None, :] for m in jnp.split(mod_x, N_MOD, axis=-1)]
        sh1_c, sc1_c, g1_c, sh2_c, sc2_c, g2_c = jnp.split(mod_c, N_MOD, axis=-1)

        hx = modulate(rmsnorm(x, norm1_g[l]), sh1_x, sc1_x)
        hc = modulate(rmsnorm(ctx, norm1_g[l]), sh1_c, sc1_c)
        fx, ux, gx = jnp.split(hx @ w_in[l], split_pts, axis=-1)
        fc, uc, gc = jnp.split(hc @ w_in[l], split_pts, axis=-1)

        ux = dwconv(ux.reshape(B_, ROWS, GRID_W, LRU_WIDTH), conv_w[l], conv_b[l]).reshape(B_, L, LRU_WIDTH)
        uc = dwconv(uc, conv_w[l], conv_b[l])
        h_zero = jnp.zeros((B_, LRU_WIDTH), jnp.float32)
        lat_dirs = []
        ctx_dirs = []
        for d, rev in ((0, False), (1, True)):
            hcd, fin = rglru_scan(uc, lru_w_a[l, d], lru_b_a[l, d], lru_w_x[l, d], lru_b_x[l, d],
                                  lru_lambda[l, d], h_zero, rev)
            hxd, _ = rglru_scan(ux, lru_w_a[l, d], lru_b_a[l, d], lru_w_x[l, d], lru_b_x[l, d],
                                lru_lambda[l, d], fin, rev)
            lat_dirs.append(hxd)
            ctx_dirs.append(hcd)
        rx = ((lat_dirs[0] + lat_dirs[1]) * jax.nn.gelu(gx.astype(jnp.float32))).astype(x.dtype)

        mx = jnp.concatenate([rmsnorm(fourier_mix(fx), fourier_out_g[l]),
                              rmsnorm(rx, lru_out_g[l])], axis=-1) @ w_out[l]
        x = x + g1_x * mx

        h2x = modulate(rmsnorm(x, norm2_g[l]), sh2_x, sc2_x)
        x = x + g2_x * peer_ffn(h2x, peer_w_q[l], peer_sub_keys[l], peer_u[l], peer_v[l])

        if update_ctx:
            rc = ((ctx_dirs[0] + ctx_dirs[1]) * jax.nn.gelu(gc.astype(jnp.float32))).astype(ctx.dtype)
            mc = jnp.concatenate([rmsnorm(fourier_mix(fc), fourier_out_g[l]),
                                  rmsnorm(rc, lru_out_g[l])], axis=-1) @ w_out[l]
            ctx = ctx + g1_c * mc
            h2c = modulate(rmsnorm(ctx, norm2_g[l]), sh2_c, sc2_c)
            ctx = ctx + g2_c * peer_ffn(h2c, peer_w_q[l], peer_sub_keys[l], peer_u[l], peer_v[l]).reshape(B_, C_LEN, D_MODEL)
    return rmsnorm(x, final_norm_g)
```

```cpp
#include <hip/hip_runtime.h>
#include <hip/hip_cooperative_groups.h>
#include <cstdio>
#include <cstdint>
namespace cg = cooperative_groups;

typedef _Float16 h16;
typedef _Float16 h16x2 __attribute__((ext_vector_type(2)));
typedef _Float16 h16x4 __attribute__((ext_vector_type(4)));
typedef _Float16 h16x8 __attribute__((ext_vector_type(8)));
typedef float f32x4 __attribute__((ext_vector_type(4)));
typedef float f32x2 __attribute__((ext_vector_type(2)));
typedef unsigned u32x4 __attribute__((ext_vector_type(4)));

#define DEVI __device__ __forceinline__
constexpr int NT = 512;
constexpr int LDS_USED = 151552;
constexpr int LDS_BYTES = LDS_USED + 16;

struct Params {
  const float *x, *c, *ctx, *c_ctx, *w_mod, *b_mod, *norm1_g, *w_in, *conv_w, *conv_b,
      *lru_w_a, *lru_b_a, *lru_w_x, *lru_b_x, *lru_lambda, *fourier_out_g, *lru_out_g,
      *w_out, *norm2_g, *peer_w_q, *peer_sub_keys, *peer_u, *peer_v, *final_norm_g;
  float* out;
  char* ws;
};

constexpr size_t OFF_MOD   = 0;
constexpr size_t OFF_TW    = OFF_MOD   + 122880;
constexpr size_t OFF_BIAS1 = OFF_TW    + 32768;
constexpr size_t OFF_BIAS3 = OFF_BIAS1 + 30720;
constexpr size_t OFF_RSTD1 = OFF_BIAS3 + 32768;
constexpr size_t OFF_SSQ2  = OFF_RSTD1 + 135168;
constexpr size_t OFF_AGG   = OFF_SSQ2  + 524288;
constexpr size_t OFF_CARRY = OFF_AGG   + 4325376;
constexpr size_t OFF_SP    = OFF_CARRY + 2097152;
constexpr size_t OFF_WF    = OFF_SP    + 4096;
constexpr size_t OFF_WIN   = OFF_WF    + 262144;
constexpr size_t OFF_WOUT  = OFF_WIN   + 3145728;
constexpr size_t OFF_WS    = OFF_WOUT  + 2097152;
constexpr size_t OFF_UB    = OFF_WS    + 4194304;
constexpr size_t OFF_VB    = OFF_UB    + 33554432;
constexpr size_t OFF_XS    = OFF_VB    + 33554432;
constexpr size_t OFF_GT    = OFF_XS    + 69206016;
constexpr size_t OFF_UX    = OFF_GT    + 67108864;
constexpr size_t OFF_GXG   = OFF_UX    + 69206016;
constexpr size_t OFF_HB    = OFF_GXG   + 67108864;
constexpr size_t OFF_A2    = OFF_HB    + 67108864;
constexpr size_t OFF_BAR   = OFF_A2    + 67108864;
constexpr size_t WS_NEED   = OFF_BAR   + 16384;

template <int CTRL> DEVI float dpp_f(float v) {
  return __builtin_bit_cast(float, __builtin_amdgcn_update_dpp(0, __builtin_bit_cast(int, v), CTRL, 0xf, 0xf, false));
}
template <int CTRL> DEVI unsigned dpp_u(unsigned v) {
  return (unsigned)__builtin_amdgcn_update_dpp(0, (int)v, CTRL, 0xf, 0xf, false);
}
DEVI float row_sum16(float v) {
  v += dpp_f<0xB1>(v); v += dpp_f<0x4E>(v); v += dpp_f<0x141>(v); v += dpp_f<0x140>(v); return v;
}
DEVI float rl_f(float v, int l) { return __builtin_bit_cast(float, __builtin_amdgcn_readlane(__builtin_bit_cast(int, v), l)); }
DEVI float wave_sum(float v) {
  v = row_sum16(v);
  return (rl_f(v, 0) + rl_f(v, 16)) + (rl_f(v, 32) + rl_f(v, 48));
}
DEVI unsigned umax(unsigned a, unsigned b) { return a > b ? a : b; }
DEVI unsigned wave_max_u(unsigned v) {
  v = umax(v, dpp_u<0xB1>(v)); v = umax(v, dpp_u<0x4E>(v)); v = umax(v, dpp_u<0x141>(v)); v = umax(v, dpp_u<0x140>(v));
  unsigned a = (unsigned)__builtin_amdgcn_readlane((int)v, 0), b = (unsigned)__builtin_amdgcn_readlane((int)v, 16);
  unsigned c = (unsigned)__builtin_amdgcn_readlane((int)v, 32), d = (unsigned)__builtin_amdgcn_readlane((int)v, 48);
  return umax(umax(a, b), umax(c, d));
}
DEVI float gelu_tanh(float x) {
  float u = 0.7978845608028654f * (x + 0.044715f * x * x * x);
  float e = __expf(2.0f * u);
  float t = 1.0f - 2.0f / (1.0f + e);
  return 0.5f * x * (1.0f + t);
}
DEVI float gelu_tanh_fast(float x) {
  const float u = 0.7978845608028654f * (x + 0.044715f * x * x * x);
  const float e = __builtin_amdgcn_exp2f(u * 2.8853900817779268f);
  const float t = 1.0f - 2.0f * __builtin_amdgcn_rcpf(1.0f + e);
  return 0.5f * x * (1.0f + t);
}
DEVI float sigmoidf_(float x) { return 1.0f / (1.0f + __expf(-x)); }
DEVI unsigned f2key(float f) { unsigned u = __float_as_uint(f); return (u & 0x80000000u) ? ~u : (u | 0x80000000u); }
DEVI float key2f(unsigned k) { unsigned u = (k & 0x80000000u) ? (k & 0x7fffffffu) : ~k; return __uint_as_float(u); }

constexpr int BM = 256, BK = 64, HALF = 128, HT = HALF * BK, KD = 1024;
DEVI int lds_byte(int r, int c) {
  int st = (r >> 4) * 2 + (c >> 5), rr = r & 15, cc = c & 31, ob = rr * 64 + cc * 2;
  return st * 1024 + (ob ^ (((ob >> 9) & 1) << 5));
}
DEVI void stage_rc(int b, int& R, int& C) {
  int st = b / 1024, sb = b % 1024, swz = sb ^ (((sb >> 9) & 1) << 5);
  R = (st >> 1) * 16 + swz / 64; C = (st & 1) * 32 + (swz % 64) / 2;
}
DEVI void tile_order(int L, int nM, int nN, int& pm, int& pn) {
  int nwg = nM * nN, wgid = L;
  { int q = nwg / 8, r = nwg % 8, xcd = wgid % 8, off = wgid / 8; wgid = (xcd < r ? xcd * (q + 1) : r * (q + 1) + (xcd - r) * q) + off; }
  int nig = 8 * nN, gid = wgid / nig, fm = gid * 8, gsz = (nM - fm) < 8 ? (nM - fm) : 8;
  pm = fm + ((wgid % nig) % gsz); pn = (wgid % nig) / gsz;
}

#define LAS __attribute__((address_space(3)))
constexpr int HTB = HALF * BK * 2;
template <int EPI, bool TRANS>
DEVI void gemm_tile(const Params& p, const h16* __restrict__ A, const h16* __restrict__ Bt, int pm, int pn, char* shmc) {
  LAS unsigned char* lds = (LAS unsigned char*)shmc;
  int tid_k = threadIdx.x; asm volatile("" : "+v"(tid_k));
  const int tid = tid_k;
  const int brow = pm * BM, bcol = pn * BM;
  const int wid = tid >> 6, lane = tid & 63, wr = wid >> 2, wc = wid & 3, fr = lane & 15, fq = lane >> 4;
  unsigned voff[2];
#pragma unroll
  for (int i = 0; i < 2; ++i) { int R, C; stage_rc(tid * 16 + i * 8192, R, C); voff[i] = (unsigned)(R * KD + C) * 2u; }
  constexpr size_t kstep = (size_t)(BK * 2), hstep = (size_t)HALF * KD * 2;
  const unsigned ldsw = (unsigned)wid * 1024u;
  const int aoff = lds_byte(wr * 64 + fr, fq * 8), boff = lds_byte(wc * 32 + fr, fq * 8);
  const char* cA = (const char*)A + (size_t)brow * KD * 2;
  const char* cB = (const char*)Bt + (size_t)bcol * KD * 2;
#define SA(b, h) (((b) * 2 + (h)) * HTB)
#define SB(b, h) ((4 + (b) * 2 + (h)) * HTB)
#define STAGE(bufoff, gbase) do { _Pragma("unroll") for (int _i = 0; _i < 2; ++_i) \
    __builtin_amdgcn_global_load_lds((const unsigned*)((const char*)(gbase) + voff[_i]), (LAS unsigned*)(lds + (bufoff) + ldsw + _i * 8192), 16, 0, 0); } while (0)
#define LDA(dst, b, h) do { _Pragma("unroll") for (int m = 0; m < 4; ++m) _Pragma("unroll") for (int k = 0; k < 2; ++k) dst[m][k] = *(const LAS h16x8*)(lds + SA(b, h) + aoff + m * 2048 + k * 1024); } while (0)
#define LDB(dst, b, h) do { _Pragma("unroll") for (int n = 0; n < 2; ++n) _Pragma("unroll") for (int k = 0; k < 2; ++k) dst[n][k] = *(const LAS h16x8*)(lds + SB(b, h) + boff + n * 2048 + k * 1024); } while (0)
#define MMA(ai, bj, At_, Bt_) do { __builtin_amdgcn_s_setprio(1); _Pragma("unroll") for (int m = 0; m < 4; ++m) _Pragma("unroll") for (int n = 0; n < 2; ++n) _Pragma("unroll") for (int k = 0; k < 2; ++k) \
      acc[ai][bj][m][n] = TRANS ? __builtin_amdgcn_mfma_f32_16x16x32_f16(Bt_[n][k], At_[m][k], acc[ai][bj][m][n], 0, 0, 0) \
                                : __builtin_amdgcn_mfma_f32_16x16x32_f16(At_[m][k], Bt_[n][k], acc[ai][bj][m][n], 0, 0, 0); \
    __builtin_amdgcn_s_setprio(0); } while (0)
#define WAIT_V(n) asm volatile("s_waitcnt vmcnt(" #n ")" ::: "memory")
#define WAIT_L(n) asm volatile("s_waitcnt lgkmcnt(" #n ")" ::: "memory")
#define BAR __builtin_amdgcn_s_barrier()
#define SCHED __builtin_amdgcn_sched_barrier(0)
  f32x4 acc[2][2][4][2];
#pragma unroll
  for (int a = 0; a < 2; ++a)
#pragma unroll
    for (int b = 0; b < 2; ++b)
#pragma unroll
      for (int m = 0; m < 4; ++m)
#pragma unroll
        for (int n = 0; n < 2; ++n) acc[a][b][m][n] = (f32x4){0.f, 0.f, 0.f, 0.f};
  h16x8 At[4][2], B0[2][2], B1[2][2];
  constexpr int nt = KD / BK;
  STAGE(SB(0, 0), cB); STAGE(SA(0, 0), cA); STAGE(SB(0, 1), cB + hstep); STAGE(SA(0, 1), cA + hstep);
  if (wr == 1) BAR;
  WAIT_V(4); BAR;
  STAGE(SB(1, 0), cB + kstep); STAGE(SA(1, 0), cA + kstep); STAGE(SB(1, 1), cB + hstep + kstep);
  WAIT_V(6); BAR;
#pragma unroll 1
  for (int t = 0; t < nt - 2; t += 2) {
    const char* a1 = cA + (size_t)(t + 1) * kstep;
    const char* a2 = cA + (size_t)(t + 2) * kstep; const char* b2 = cB + (size_t)(t + 2) * kstep;
    const char* a3 = a2 + kstep; const char* b3 = b2 + kstep;
    LDB(B0, 0, 0); SCHED; LDA(At, 0, 0); STAGE(SA(1, 1), a1 + hstep);
    WAIT_L(8); BAR; WAIT_L(0); MMA(0, 0, At, B0); BAR; SCHED;
    LDB(B1, 0, 1); STAGE(SB(0, 0), b2);
    BAR; WAIT_L(0); MMA(0, 1, At, B1); BAR;
    LDA(At, 0, 1); STAGE(SA(0, 0), a2);
    BAR; WAIT_L(0); MMA(1, 0, At, B0); BAR; SCHED;
    STAGE(SB(0, 1), b2 + hstep);
    WAIT_V(6); BAR; MMA(1, 1, At, B1); BAR;
    LDB(B0, 1, 0); SCHED; LDA(At, 1, 0); STAGE(SA(0, 1), a2 + hstep);
    WAIT_L(8); BAR; WAIT_L(0); MMA(0, 0, At, B0); BAR; SCHED;
    LDB(B1, 1, 1); STAGE(SB(1, 0), b3);
    BAR; WAIT_L(0); MMA(0, 1, At, B1); BAR;
    LDA(At, 1, 1); STAGE(SA(1, 0), a3);
    BAR; WAIT_L(0); MMA(1, 0, At, B0); BAR; SCHED;
    STAGE(SB(1, 1), b3 + hstep);
    WAIT_V(6); BAR; MMA(1, 1, At, B1); BAR;
  }
  { LDB(B0, 0, 0); LDA(At, 0, 0); STAGE(SA(1, 1), cA + (size_t)(nt - 1) * kstep + hstep);
    BAR; WAIT_L(0); MMA(0, 0, At, B0); BAR;
    LDB(B1, 0, 1); BAR; WAIT_L(0); MMA(0, 1, At, B1); BAR;
    LDA(At, 0, 1); WAIT_V(4); BAR; WAIT_L(0); MMA(1, 0, At, B0); MMA(1, 1, At, B1); BAR; }
  { LDB(B0, 1, 0); LDA(At, 1, 0); WAIT_V(2); BAR; WAIT_L(0); MMA(0, 0, At, B0); BAR;
    LDB(B1, 1, 1); WAIT_V(0); BAR; WAIT_L(0); MMA(0, 1, At, B1); BAR;
    LDA(At, 1, 1); BAR; WAIT_L(0); MMA(1, 0, At, B0); MMA(1, 1, At, B1); BAR; }
  if (wr == 0) BAR;
#undef SA
#undef SB
#undef STAGE
#undef LDA
#undef LDB
#undef MMA
  int tid_e = threadIdx.x; asm volatile("" : "+v"(tid_e));
  {
  const int tid = tid_e, wid = tid >> 6, lane = tid & 63, wr = wid >> 2, wc = wid & 3, fr = lane & 15, fq = lane >> 4;
  (void)lane; (void)wr; (void)wc; (void)fr; (void)fq;
  if constexpr (EPI == 1) {
    const float* RSTD1 = (const float*)(p.ws + OFF_RSTD1);
    const float* BIAS1 = (const float*)(p.ws + OFF_BIAS1);
    const int bb = brow < 32768 ? (brow >> 13) : 4;
    if constexpr (!TRANS) {
      h16* GT = (h16*)(p.ws + OFF_GT);
#pragma unroll
      for (int ai = 0; ai < 2; ++ai)
#pragma unroll
        for (int m = 0; m < 4; ++m) {
          const int row0 = brow + ai * 128 + wr * 64 + m * 16 + fq * 4;
          const f32x4 rs = *(const f32x4*)(RSTD1 + row0);
#pragma unroll
          for (int bj = 0; bj < 2; ++bj)
#pragma unroll
            for (int n = 0; n < 2; ++n) {
              const int col = bcol + bj * 128 + wc * 32 + n * 16 + fr;
              const float bias = BIAS1[bb * 1536 + col];
              const f32x4 gv = acc[ai][bj][m][n] * rs + bias;
              *(h16x4*)(GT + ((size_t)(bb * 512 + col) * 8192 + (row0 & 8191))) = (h16x4){(h16)gv[0], (h16)gv[1], (h16)gv[2], (h16)gv[3]};
            }
        }
    } else {
      h16* UX = (h16*)(p.ws + OFF_UX);
      h16* GXG = (h16*)(p.ws + OFF_GXG);
#pragma unroll
      for (int ai = 0; ai < 2; ++ai)
#pragma unroll
        for (int m = 0; m < 4; ++m) {
          const int row = brow + ai * 128 + wr * 64 + m * 16 + fr;
          const float rs = RSTD1[row];
#pragma unroll
          for (int bj = 0; bj < 2; ++bj)
#pragma unroll
            for (int n = 0; n < 2; ++n) {
              const int col0 = bcol + bj * 128 + wc * 32 + n * 16 + fq * 4;
              const f32x4 bias = *(const f32x4*)(BIAS1 + bb * 1536 + col0);
              f32x4 v = acc[ai][bj][m][n] * rs + bias;
              if (pn < 4) *(h16x4*)(UX + (size_t)row * 512 + (col0 - 512)) = (h16x4){(h16)v[0], (h16)v[1], (h16)v[2], (h16)v[3]};
              else { v[0] = gelu_tanh(v[0]); v[1] = gelu_tanh(v[1]); v[2] = gelu_tanh(v[2]); v[3] = gelu_tanh(v[3]); *(h16x4*)(GXG + (size_t)row * 512 + (col0 - 1024)) = (h16x4){(h16)v[0], (h16)v[1], (h16)v[2], (h16)v[3]}; }
            }
        }
    }
  } else if constexpr (EPI == 2) {
    static_assert(EPI != 2 || TRANS, "EPI 2 uses transposed accumulators");
    const float* MOD = (const float*)(p.ws + OFF_MOD);
    float* SSQ2 = (float*)(p.ws + OFF_SSQ2);
    h16* H2S = (h16*)(p.ws + OFF_XS);
    h16* X1 = (h16*)(p.ws + OFF_GXG);
    float* red = (float*)shmc;
    const int b = brow >> 13;
    f32x4 g1v[2][2], gsv[2][2];
#pragma unroll
    for (int bj = 0; bj < 2; ++bj)
#pragma unroll
      for (int n = 0; n < 2; ++n) {
        const int col0 = bcol + bj * 128 + wc * 32 + n * 16 + fq * 4;
        g1v[bj][n] = *(const f32x4*)(MOD + b * 6144 + 2048 + col0);
        gsv[bj][n] = *(const f32x4*)(p.norm2_g + col0) * (*(const f32x4*)(MOD + b * 6144 + 4096 + col0) + 1.0f);
      }
#pragma unroll
    for (int am = 0; am < 4; ++am) {
      const int ai = am >> 1, m0 = (am & 1) * 2;
      f32x4 xv[2][2][2];
#pragma unroll
      for (int mm = 0; mm < 2; ++mm)
#pragma unroll
        for (int bj = 0; bj < 2; ++bj)
#pragma unroll
          for (int n = 0; n < 2; ++n)
            xv[mm][bj][n] = *(const f32x4*)(p.x + (size_t)(brow + ai * 128 + wr * 64 + (m0 + mm) * 16 + fr) * 1024 + bcol + bj * 128 + wc * 32 + n * 16 + fq * 4);
      __builtin_amdgcn_sched_barrier(0);
#pragma unroll
      for (int mm = 0; mm < 2; ++mm) {
        const int m = m0 + mm;
        const int row = brow + ai * 128 + wr * 64 + m * 16 + fr;
        float ss = 0.0f;
#pragma unroll
        for (int bj = 0; bj < 2; ++bj)
#pragma unroll
          for (int n = 0; n < 2; ++n) {
            const int col0 = bcol + bj * 128 + wc * 32 + n * 16 + fq * 4;
            const size_t o = (size_t)row * 1024 + col0;
            const f32x4 x1 = xv[mm][bj][n] + g1v[bj][n] * acc[ai][bj][m][n];
            const f32x4 hh = x1 * gsv[bj][n];
            *(h16x4*)(X1 + o) = (h16x4){(h16)x1[0], (h16)x1[1], (h16)x1[2], (h16)x1[3]};
            *(h16x4*)(H2S + o) = (h16x4){(h16)hh[0], (h16)hh[1], (h16)hh[2], (h16)hh[3]};
            ss += (x1[0] * x1[0] + x1[1] * x1[1]) + (x1[2] * x1[2] + x1[3] * x1[3]);
          }
        ss += __shfl_xor(ss, 16); ss += __shfl_xor(ss, 32);
        if (fq == 0) red[wc * 256 + ai * 128 + wr * 64 + m * 16 + fr] = ss;
      }
    }
    __syncthreads();
    if (tid < 256) {
      const int r = tid;
      SSQ2[(size_t)(brow + r) * 4 + pn] = (red[r] + red[256 + r]) + (red[512 + r] + red[768 + r]);
    }
  } else if constexpr (EPI == 3) {
    const float* SSQ2 = (const float*)(p.ws + OFF_SSQ2);
    const float* BIAS3 = (const float*)(p.ws + OFF_BIAS3);
    unsigned* TOPK = (unsigned*)(p.ws + OFF_UX);
    float* sc = (float*)shmc;
    float* rstd_l = (float*)(shmc + 139264);
    const int b = brow >> 13;
    if (tid < 256) {
      const f32x4 q = *(const f32x4*)(SSQ2 + (size_t)(brow + tid) * 4);
      rstd_l[tid] = rsqrtf(((q[0] + q[1]) + (q[2] + q[3])) * (1.0f / 1024.0f) + 1e-6f);
    }
#pragma unroll
    for (int bj = 0; bj < 2; ++bj) {
      __syncthreads();
#pragma unroll
      for (int ai = 0; ai < 2; ++ai)
#pragma unroll
        for (int m = 0; m < 4; ++m) {
          const int r0 = ai * 128 + wr * 64 + m * 16 + fq * 4;
          const f32x4 rstd = *(const f32x4*)(rstd_l + r0);
#pragma unroll
          for (int n = 0; n < 2; ++n) {
            const int cl = wc * 32 + n * 16 + fr;
            const float bias = BIAS3[b * 2048 + bcol + bj * 128 + cl];
            const int pc = cl + 4 * (cl >> 6);
#pragma unroll
            for (int j = 0; j < 4; ++j) sc[(r0 + j) * 136 + pc] = acc[ai][bj][m][n][j] * rstd[j] + bias;
          }
        }
      __syncthreads();
      {
        const int row = tid >> 1, hf = tid & 1;
        const float* rp = sc + row * 136 + hf * 68;
        unsigned Lq[4][16];
#pragma unroll
        for (int c = 0; c < 4; ++c)
#pragma unroll
          for (int k = 0; k < 16; ++k) Lq[c][k] = 0u;
#pragma unroll
        for (int i4 = 0; i4 < 4; ++i4) {
          f32x4 v[4];
#pragma unroll
          for (int c = 0; c < 4; ++c) v[c] = *(const f32x4*)(rp + (c * 4 + i4) * 4);
#pragma unroll
          for (int j = 0; j < 4; ++j)
#pragma unroll
            for (int c = 0; c < 4; ++c) {
              unsigned x = (f2key(v[c][j]) & ~127u) | (unsigned)(hf * 64 + (c * 4 + i4) * 4 + j);
#pragma unroll
              for (int k = 0; k < 16; ++k) { const unsigned hi = umax(Lq[c][k], x); x = Lq[c][k] < x ? Lq[c][k] : x; Lq[c][k] = hi; }
            }
        }
        auto merge16 = [](unsigned (&A)[16], const unsigned (&B)[16]) {
#pragma unroll
          for (int k = 0; k < 16; ++k) A[k] = umax(A[k], B[15 - k]);
#pragma unroll
          for (int d = 8; d >= 1; d >>= 1)
#pragma unroll
            for (int k = 0; k < 16; ++k) if ((k & d) == 0) { const unsigned a = A[k], c2 = A[k + d]; A[k] = umax(a, c2); A[k + d] = a < c2 ? a : c2; }
        };
        merge16(Lq[0], Lq[1]); merge16(Lq[2], Lq[3]); merge16(Lq[0], Lq[2]);
        unsigned (&L)[16] = Lq[0];
        unsigned C[16];
#pragma unroll
        for (int k = 0; k < 16; ++k) C[k] = umax(L[k], dpp_u<0xB1>(L[15 - k]));
#pragma unroll
        for (int d = 8; d >= 1; d >>= 1)
#pragma unroll
          for (int k = 0; k < 16; ++k) if ((k & d) == 0) { const unsigned a = C[k], c2 = C[k + d]; C[k] = umax(a, c2); C[k + d] = a < c2 ? a : c2; }
        unsigned* dst = TOPK + ((size_t)(brow + row) * 16 + (pn * 2 + bj)) * 16;
        if (hf == 0) { *(u32x4*)dst = (u32x4){C[0], C[1], C[2], C[3]}; *(u32x4*)(dst + 4) = (u32x4){C[4], C[5], C[6], C[7]}; }
        else { *(u32x4*)(dst + 8) = (u32x4){C[8], C[9], C[10], C[11]}; *(u32x4*)(dst + 12) = (u32x4){C[12], C[13], C[14], C[15]}; }
      }
    }
  }
  }
  __syncthreads();
}

DEVI void phase0a(const Params& p, char* shm, int bid, int nb) {
  const int tid = threadIdx.x;
  float* MOD = (float*)(p.ws + OFF_MOD);
  h16* WIN = (h16*)(p.ws + OFF_WIN);
  h16* WOUT = (h16*)(p.ws + OFF_WOUT);
  h16* WSs = (h16*)(p.ws + OFF_WS);
  for (int u = bid; u < 1089; u += nb) {
    __syncthreads();
    if (u < 192) {
      float* s = (float*)shm; float* red = s + 5120;
      for (int i = tid; i < 5120; i += NT) { const int v = i >> 10, k = i & 1023; const float xv = v < 4 ? p.c[v * 1024 + k] : p.c_ctx[k]; s[i] = xv / (1.0f + expf(-xv)); }
      __syncthreads();
      const int cl = tid & 31, kg = tid >> 5, n = u * 32 + cl;
      float a0 = 0, a1 = 0, a2 = 0, a3 = 0, a4 = 0;
      for (int k = kg; k < 1024; k += 16) { const float w = p.w_mod[(size_t)k * 6144 + n]; a0 += s[k] * w; a1 += s[1024 + k] * w; a2 += s[2048 + k] * w; a3 += s[3072 + k] * w; a4 += s[4096 + k] * w; }
      float* rr = red + (kg * 32 + cl) * 5; rr[0] = a0; rr[1] = a1; rr[2] = a2; rr[3] = a3; rr[4] = a4;
      __syncthreads();
      if (tid < 160) { const int v = tid >> 5, c2 = tid & 31; float sum = 0; for (int g = 0; g < 16; ++g) sum += red[(g * 32 + c2) * 5 + v]; MOD[v * 6144 + u * 32 + c2] = sum + p.b_mod[u * 32 + c2]; }
    } else if (u < 320) {
      const int uu = u - 192, h = uu >> 4, k0 = (uu & 15) * 64;
      float* wt = (float*)shm; float* bs = wt + 64 * 65;
      for (int i = tid; i < 4096; i += NT) {
        const int kk = i >> 6, j = i & 63;
        wt[kk * 65 + j] = p.w_in[(size_t)(k0 + kk) * 1536 + h * 64 + j];
        const int pp = kk, mf = pp <= 32 ? pp : 64 - pp; const float ang = (float)((mf * j) & 63) * (1.0f / 32.0f);
        bs[i] = pp <= 32 ? cospif(ang) : sinpif(ang);
      }
      __syncthreads();
      for (int o = tid; o < 4096; o += NT) {
        const int kk = o & 63, pp = o >> 6; float sum = 0;
#pragma unroll 8
        for (int j = 0; j < 64; ++j) sum += wt[kk * 65 + j] * bs[pp * 64 + j];
        WIN[(size_t)(h * 64 + pp) * 1024 + k0 + kk] = (h16)sum;
      }
    } else if (u < 832) {
      const bool isout = u >= 576; const int uu = isout ? u - 576 : u - 320;
      const int n0 = (uu >> 4) * 64 + (isout ? 0 : 512), k0 = (uu & 15) * 64;
      const float* src = isout ? p.w_out : p.w_in; const int ld = isout ? 1024 : 1536;
      h16* dst = isout ? WOUT : WIN;
      float* t = (float*)shm;
      for (int i = tid; i < 4096; i += NT) { const int kk = i >> 6, nn = i & 63; t[kk * 65 + nn] = src[(size_t)(k0 + kk) * ld + n0 + nn]; }
      __syncthreads();
      for (int o = tid; o < 4096; o += NT) { const int nn = o >> 6, kk = o & 63; dst[(size_t)(n0 + nn) * 1024 + k0 + kk] = (h16)t[kk * 65 + nn]; }
    } else if (u < 1088) {
      const int uu = u - 832, g = uu >> 4, k0 = (uu & 15) * 64;
      float* q = (float*)shm; float* ky = q + 64 * 129;
      for (int i = tid; i < 64 * 128; i += NT) { const int kk = i >> 7, d = i & 127; q[kk * 129 + d] = p.peer_w_q[(size_t)(k0 + kk) * 2048 + g * 128 + d]; }
      for (int i = tid; i < 128 * 128; i += NT) { const int key = i >> 7, d = i & 127; ky[key * 129 + d] = p.peer_sub_keys[(size_t)(g * 128 + key) * 128 + d]; }
      __syncthreads();
      const int tx = tid & 15, ty = tid >> 4;
      float a[4][4] = {};
      for (int d = 0; d < 128; ++d) {
        float qv[4], kv[4];
#pragma unroll
        for (int i = 0; i < 4; ++i) { qv[i] = q[(tx * 4 + i) * 129 + d]; kv[i] = ky[(ty * 4 + i) * 129 + d]; }
#pragma unroll
        for (int ki = 0; ki < 4; ++ki)
#pragma unroll
          for (int qi = 0; qi < 4; ++qi) a[ki][qi] += kv[ki] * qv[qi];
      }
#pragma unroll
      for (int ki = 0; ki < 4; ++ki) {
        h16x4 o = {(h16)a[ki][0], (h16)a[ki][1], (h16)a[ki][2], (h16)a[ki][3]};
        *(h16x4*)(WSs + (size_t)(g * 128 + ty * 4 + ki) * 1024 + k0 + tx * 4) = o;
      }
    } else {
      f32x2* TW = (f32x2*)(p.ws + OFF_TW);
      for (int j = tid; j < 4096; j += NT) { float s, c; sincospif((float)j * (1.0f / 4096.0f), &s, &c); TW[j] = (f32x2){c, -s}; }
    }
  }
  {
    h16* WF = (h16*)(p.ws + OFF_WF); float* SP = (float*)(p.ws + OFF_SP);
    for (int i = bid * NT + tid; i < 131072; i += nb * NT) {
      const int j = i & 7, ln = (i >> 3) & 63, fragi = i >> 9;
      const int ks = fragi & 3, mt = (fragi >> 2) & 1, gate = (fragi >> 3) & 1, dh = fragi >> 4;
      const int cout = 32 * mt + (ln & 31), cin = 16 * ks + 8 * (ln >> 5) + j;
      const float* W = gate ? p.lru_w_x : p.lru_w_a;
      WF[i] = (h16)W[((size_t)dh * 64 + cin) * 64 + cout];
    }
    for (int i = bid * NT + tid; i < 1024; i += nb * NT) SP[i] = -8.0f * 1.4426950408889634f * log1pf(expf(-p.lru_lambda[i]));
  }
  {
    const int wid = tid >> 6, lane = tid & 63, gw = bid * 8 + wid, nw = nb * 8;
    for (int row = gw; row < 32768; row += nw) {
      const bool isv = row >= 16384; const int rr = row & 16383;
      const f32x4* src = (const f32x4*)((isv ? p.peer_v : p.peer_u) + (size_t)rr * 1024 + lane * 16);
      const f32x4 a = src[0], b = src[1], c = src[2], d = src[3];
      float am = 0.0f;
#pragma unroll
      for (int j = 0; j < 4; ++j) am = fmaxf(fmaxf(am, fabsf(a[j])), fmaxf(fmaxf(fabsf(b[j]), fabsf(c[j])), fabsf(d[j])));
      am = __uint_as_float(wave_max_u(__float_as_uint(am)));
      u32x4 o;
      if (isv) {
        const float sc = am > 0.0f ? 448.0f / am : 1.0f;
        int w;
        w = __builtin_amdgcn_cvt_pk_fp8_f32(a[0] * sc, a[1] * sc, 0, false); w = __builtin_amdgcn_cvt_pk_fp8_f32(a[2] * sc, a[3] * sc, w, true); o[0] = (unsigned)w;
        w = __builtin_amdgcn_cvt_pk_fp8_f32(b[0] * sc, b[1] * sc, 0, false); w = __builtin_amdgcn_cvt_pk_fp8_f32(b[2] * sc, b[3] * sc, w, true); o[1] = (unsigned)w;
        w = __builtin_amdgcn_cvt_pk_fp8_f32(c[0] * sc, c[1] * sc, 0, false); w = __builtin_amdgcn_cvt_pk_fp8_f32(c[2] * sc, c[3] * sc, w, true); o[2] = (unsigned)w;
        w = __builtin_amdgcn_cvt_pk_fp8_f32(d[0] * sc, d[1] * sc, 0, false); w = __builtin_amdgcn_cvt_pk_fp8_f32(d[2] * sc, d[3] * sc, w, true); o[3] = (unsigned)w;
      } else {
        const float sc = am > 0.0f ? 127.0f / am : 1.0f;
        auto q4 = [&](const f32x4& v) -> unsigned {
          const int q0 = (int)rintf(v[0] * sc), q1 = (int)rintf(v[1] * sc), q2 = (int)rintf(v[2] * sc), q3 = (int)rintf(v[3] * sc);
          return (unsigned)(q0 & 255) | ((unsigned)(q1 & 255) << 8) | ((unsigned)(q2 & 255) << 16) | ((unsigned)(q3 & 255) << 24);
        };
        o[0] = q4(a); o[1] = q4(b); o[2] = q4(c); o[3] = q4(d);
      }
      *(u32x4*)(p.ws + (isv ? OFF_VB : OFF_UB) + (size_t)rr * 1024 + lane * 16) = o;
      if (lane == 0) ((float*)(p.ws + (isv ? OFF_VB : OFF_UB) + 16777216))[rr] = am * (isv ? (1.0f / 448.0f) : (1.0f / 127.0f));
    }
  }
}

DEVI void phase0b(const Params& p, char* shm, int bid, int nb) {
  const int tid = threadIdx.x, wid = tid >> 6, lane = tid & 63, gw = bid * 8 + wid, nw = nb * 8;
  const float* MOD = (const float*)(p.ws + OFF_MOD);
  h16* XS = (h16*)(p.ws + OFF_XS);
  float* RSTD1 = (float*)(p.ws + OFF_RSTD1);
  for (int tok = gw; tok < 33792; tok += nw) {
    const int bb = tok < 32768 ? (tok >> 13) : 4;
    const float* src = tok < 32768 ? p.x + (size_t)tok * 1024 : p.ctx + (size_t)(tok - 32768) * 1024;
    const float* mod = MOD + bb * 6144;
    float ss = 0;
#pragma unroll
    for (int i = 0; i < 4; ++i) {
      const int k = i * 256 + lane * 4;
      const f32x4 xv = *(const f32x4*)(src + k), g = *(const f32x4*)(p.norm1_g + k), sc = *(const f32x4*)(mod + 1024 + k);
      ss += (xv[0] * xv[0] + xv[1] * xv[1]) + (xv[2] * xv[2] + xv[3] * xv[3]);
      const f32x4 y = xv * g * (sc + 1.0f);
      h16x4 o = {(h16)y[0], (h16)y[1], (h16)y[2], (h16)y[3]};
      *(h16x4*)(XS + (size_t)tok * 1024 + k) = o;
    }
    ss = wave_sum(ss);
    if (lane == 0) RSTD1[tok] = rsqrtf(ss * (1.0f / 1024.0f) + 1e-6f);
  }
  const h16* WIN = (const h16*)(p.ws + OFF_WIN);
  const h16* WSs = (const h16*)(p.ws + OFF_WS);
  float* BIAS1 = (float*)(p.ws + OFF_BIAS1);
  float* BIAS3 = (float*)(p.ws + OFF_BIAS3);
  for (int n = gw; n < 1536 + 2048; n += nw) {
    const bool is3 = n >= 1536; const int nn = is3 ? n - 1536 : n;
    const h16* wrow = (is3 ? WSs : WIN) + (size_t)nn * 1024;
    const h16x8 w0 = *(const h16x8*)(wrow + lane * 8), w1 = *(const h16x8*)(wrow + 512 + lane * 8);
    const int nv = is3 ? 4 : 5;
    for (int bb = 0; bb < nv; ++bb) {
      const float* sh = MOD + bb * 6144 + (is3 ? 3072 : 0);
      float s = 0;
#pragma unroll
      for (int j = 0; j < 8; ++j) s += (float)w0[j] * sh[lane * 8 + j] + (float)w1[j] * sh[512 + lane * 8 + j];
      s = wave_sum(s);
      if (lane == 0) { if (is3) BIAS3[bb * 2048 + nn] = s; else BIAS1[bb * 1536 + nn] = s; }
    }
  }
}

DEVI void phase1(const Params& p, char* shm, int bid, int nb) {
  const h16* XS = (const h16*)(p.ws + OFF_XS);
  const h16* WIN = (const h16*)(p.ws + OFF_WIN);
  for (int i = 0;; ++i) {
    const long L = (long)i * nb + bid; if (L >= 776) break;
    int pm, pn;
    if (L < 768) tile_order((int)L, 128, 6, pm, pn); else { pm = 128 + (int)(L - 768) / 2; pn = 2 + (int)(L - 768) % 2; }
    if (pn < 2) gemm_tile<1, false>(p, XS, WIN, pm, pn, shm); else gemm_tile<1, true>(p, XS, WIN, pm, pn, shm);
  }
}

typedef float f32x16 __attribute__((ext_vector_type(16)));
template <int CTRL> DEVI float dpp_old(float v, float old) {
  return __builtin_bit_cast(float, __builtin_amdgcn_update_dpp(__builtin_bit_cast(int, old), __builtin_bit_cast(int, v), CTRL, 0xf, 0xf, false));
}
template <int PAT> DEVI float swz(float v) { return __builtin_bit_cast(float, __builtin_amdgcn_ds_swizzle(__builtin_bit_cast(int, v), PAT)); }
template <int D> DEVI void scan32(float& a, float& b, int lane) {
#define LSTEP(CTRL) { const float ap = dpp_old<CTRL>(a, 1.0f), bp = dpp_old<CTRL>(b, 0.0f); b = a * bp + b; a = a * ap; }
  if (D == 0) {
    LSTEP(0x111) LSTEP(0x112) LSTEP(0x114) LSTEP(0x118)
    const float ap = __builtin_bit_cast(float, __builtin_amdgcn_update_dpp(__builtin_bit_cast(int, 1.0f), __builtin_bit_cast(int, a), 0x142, 0xa, 0xf, false));
    const float bp = __builtin_bit_cast(float, __builtin_amdgcn_update_dpp(__builtin_bit_cast(int, 0.0f), __builtin_bit_cast(int, b), 0x142, 0xa, 0xf, false));
    b = a * bp + b; a = a * ap;
  } else {
    LSTEP(0x101) LSTEP(0x102) LSTEP(0x104) LSTEP(0x108)
    float ap = swz<0x200>(a), bp = swz<0x200>(b);
    if (lane & 16) { ap = 1.0f; bp = 0.0f; }
    b = a * bp + b; a = a * ap;
  }
#undef LSTEP
}
constexpr int LRU_WAVE_LDS = 18432, LRU_SSQ_OFF = 8 * LRU_WAVE_LDS;
template <int MODE>
DEVI void lru_unit(const Params& p, char* shm, int q) {
  int tid_o = threadIdx.x; asm volatile("" : "+v"(tid_o));
  const int tid = tid_o, wid = __builtin_amdgcn_readfirstlane(tid >> 6), lane = tid & 63, ch = wid * 64 + lane, half = lane >> 5, ln = lane & 31;
  const h16* UX = (const h16*)(p.ws + OFF_UX);
  h16* xh = (h16*)(shm + wid * LRU_WAVE_LDS);
  h16* hx = xh + 4608;
  float* ssq_l = (float*)(shm + LRU_SSQ_OFF);
  int tok0, lo, hi, b, jj;
  if (q < 512) { tok0 = q * 64; lo = tok0; hi = tok0 + 64; b = q >> 7; jj = 4 + (q & 127); }
  else { const int cq = q - 512; b = cq >> 2; lo = 32768 + b * 256; hi = lo + 256; tok0 = lo + (cq & 3) * 64; jj = cq & 3; }
  {
    const float cw0 = p.conv_w[ch], cw1 = p.conv_w[512 + ch], cw2 = p.conv_w[1024 + ch], cw3 = p.conv_w[1536 + ch], cb = p.conv_b[ch];
    float xv[67];
#pragma unroll
    for (int i = 0; i < 67; ++i) {
      const int tk = tok0 - 2 + i, tkc = tk < lo ? lo : (tk >= hi ? hi - 1 : tk);
      xv[i] = (float)UX[(size_t)tkc * 512 + ch];
    }
    __builtin_amdgcn_sched_barrier(0);
#pragma unroll
    for (int i = 0; i < 67; ++i) {
      const int tk = tok0 - 2 + i;
      const float msk = (tk >= lo && tk < hi) ? 1.0f : 0.0f;
      xv[i] *= msk;
    }
#pragma unroll
    for (int t = 0; t < 64; ++t) xh[t * 72 + lane] = (h16)(cb + cw0 * xv[t] + cw1 * xv[t + 1] + cw2 * xv[t + 2] + cw3 * xv[t + 3]);
  }
  h16x8 Bf[2][4];
#pragma unroll
  for (int nt = 0; nt < 2; ++nt)
#pragma unroll
    for (int ks = 0; ks < 4; ++ks) Bf[nt][ks] = *(const h16x8*)(xh + (32 * nt + ln) * 72 + 16 * ks + 8 * half);
  const h16x8* WF = (const h16x8*)(p.ws + OFF_WF);
  const float* SP = (const float*)(p.ws + OFF_SP);
  const h16* GXG = (const h16*)(p.ws + OFF_GXG);
  const float* CARRY = (const float*)(p.ws + OFF_CARRY);
  f32x2* AGG = (f32x2*)(p.ws + OFF_AGG);
  float ssq[2] = {0.0f, 0.0f};
#pragma unroll 1
  for (int mt = 0; mt < 2; ++mt) {
#pragma unroll
    for (int dd = 0; dd < 2; ++dd) {
      const int d = 1 - dd;
      int lane_o = threadIdx.x & 63; asm volatile("" : "+v"(lane_o));
      const int lane = lane_o, half = lane >> 5, ln = lane & 31;
      f32x16 aa[2], ax[2];
#pragma unroll
      for (int nt = 0; nt < 2; ++nt)
#pragma unroll
        for (int r = 0; r < 16; ++r) { aa[nt][r] = 0.0f; ax[nt][r] = 0.0f; }
      const h16x8* wfa = WF + ((size_t)(((d * 8 + wid) * 2 + 0) * 8 + mt * 4) * 64 + lane);
      const h16x8* wfx = WF + ((size_t)(((d * 8 + wid) * 2 + 1) * 8 + mt * 4) * 64 + lane);
#pragma unroll
      for (int ks = 0; ks < 4; ++ks) {
        const h16x8 Aa = wfa[ks * 64], Ax = wfx[ks * 64];
#pragma unroll
        for (int nt = 0; nt < 2; ++nt) {
          aa[nt] = __builtin_amdgcn_mfma_f32_32x32x16_f16(Aa, Bf[nt][ks], aa[nt], 0, 0, 0);
          ax[nt] = __builtin_amdgcn_mfma_f32_32x32x16_f16(Ax, Bf[nt][ks], ax[nt], 0, 0, 0);
        }
      }
#pragma unroll
      for (int g = 0; g < 4; ++g) {
        const int c0 = 32 * mt + 8 * g + 4 * half;
        const f32x4 ba4 = *(const f32x4*)(p.lru_b_a + d * 512 + wid * 64 + c0), bx4 = *(const f32x4*)(p.lru_b_x + d * 512 + wid * 64 + c0);
        const f32x4 sp4 = *(const f32x4*)(SP + d * 512 + wid * 64 + c0);
#pragma unroll
        for (int nt = 0; nt < 2; ++nt) {
          const h16x4 xc4 = *(const h16x4*)(xh + (32 * nt + ln) * 72 + c0);
#pragma unroll
          for (int j = 0; j < 4; ++j) {
            const int r = 4 * g + j;
            const float rg = __builtin_amdgcn_rcpf(1.0f + __builtin_amdgcn_exp2f((aa[nt][r] + ba4[j]) * -1.4426950408889634f));
            const float ig = __builtin_amdgcn_rcpf(1.0f + __builtin_amdgcn_exp2f((ax[nt][r] + bx4[j]) * -1.4426950408889634f));
            const float a = __builtin_amdgcn_exp2f(rg * sp4[j]);
            const float em = __builtin_fmaf(-a, a, 1.0f);
            aa[nt][r] = a; ax[nt][r] = __builtin_amdgcn_sqrtf(em) * ig * (float)xc4[j];
          }
        }
      }
#pragma unroll
      for (int nt = 0; nt < 2; ++nt)
#pragma unroll
        for (int r = 0; r < 16; ++r) { float a = aa[nt][r], bv = ax[nt][r]; if (d) scan32<1>(a, bv, lane); else scan32<0>(a, bv, lane); aa[nt][r] = a; ax[nt][r] = bv; }
#pragma unroll
      for (int r = 0; r < 16; ++r) {
        if (d == 0) { const float ta = swz<0x3E0>(aa[0][r]), tb = swz<0x3E0>(ax[0][r]); ax[1][r] = aa[1][r] * tb + ax[1][r]; aa[1][r] = aa[1][r] * ta; }
        else        { const float ta = swz<0x000>(aa[1][r]), tb = swz<0x000>(ax[1][r]); ax[0][r] = aa[0][r] * tb + ax[0][r]; aa[0][r] = aa[0][r] * ta; }
      }
      if (MODE == 0) {
        if (ln == (d ? 0 : 31)) {
#pragma unroll
          for (int r = 0; r < 16; ++r) {
            const int c = 32 * mt + (r & 3) + 8 * (r >> 2) + 4 * half;
            AGG[((size_t)(b * 132 + jj) * 2 + d) * 512 + wid * 64 + c] = d ? (f32x2){aa[0][r], ax[0][r]} : (f32x2){aa[1][r], ax[1][r]};
          }
        }
      } else {
#pragma unroll
        for (int g = 0; g < 4; ++g) {
          const int c0 = 32 * mt + 8 * g + 4 * half;
          const f32x4 h0 = *(const f32x4*)(CARRY + ((size_t)(b * 128 + (q & 127)) * 2 + d) * 512 + wid * 64 + c0);
#pragma unroll
          for (int nt = 0; nt < 2; ++nt) {
            h16* hp = hx + (32 * nt + ln) * 72 + c0;
            f32x4 hv;
#pragma unroll
            for (int j = 0; j < 4; ++j) hv[j] = aa[nt][4 * g + j] * h0[j] + ax[nt][4 * g + j];
            if (d == 1) {
              *(h16x4*)hp = (h16x4){(h16)hv[0], (h16)hv[1], (h16)hv[2], (h16)hv[3]};
            } else {
              const h16x4 hb4 = *(const h16x4*)hp;
              const h16x4 gxh = *(const h16x4*)(GXG + (size_t)(tok0 + 32 * nt + ln) * 512 + wid * 64 + c0);
              const f32x4 gx4 = {(float)gxh[0], (float)gxh[1], (float)gxh[2], (float)gxh[3]};
              h16x4 o;
#pragma unroll
              for (int j = 0; j < 4; ++j) { const float rx = (hv[j] + (float)hb4[j]) * gx4[j]; ssq[nt] += rx * rx; o[j] = (h16)rx; }
              *(h16x4*)hp = o;
            }
          }
        }
      }
      __builtin_amdgcn_sched_barrier(0);
    }
  }
  if (MODE == 1) {
    int lane_o = threadIdx.x & 63; asm volatile("" : "+v"(lane_o));
    const int lane = lane_o, half = lane >> 5, ln = lane & 31;
#pragma unroll
    for (int nt = 0; nt < 2; ++nt) {
      const float s = ssq[nt] + __shfl_xor(ssq[nt], 32);
      if (half == 0) ssq_l[wid * 64 + 32 * nt + ln] = s;
    }
    __syncthreads();
    h16* A2 = (h16*)(p.ws + OFF_A2);
    const int cc = (lane & 7) * 8;
    const f32x4 ga = *(const f32x4*)(p.lru_out_g + wid * 64 + cc), gb = *(const f32x4*)(p.lru_out_g + wid * 64 + cc + 4);
#pragma unroll 2
    for (int i = 0; i < 8; ++i) {
      const int t = (lane >> 3) + 8 * i;
      float tot = 0;
#pragma unroll
      for (int w = 0; w < 8; ++w) tot += ssq_l[w * 64 + t];
      const float rstd = rsqrtf(tot * (1.0f / 512.0f) + 1e-6f);
      const h16x8 rv = *(const h16x8*)(hx + t * 72 + cc);
      h16x8 o;
#pragma unroll
      for (int j = 0; j < 4; ++j) { o[j] = (h16)((float)rv[j] * rstd * ga[j]); o[4 + j] = (h16)((float)rv[4 + j] * rstd * gb[j]); }
      *(h16x8*)(A2 + (size_t)(tok0 + t) * 1024 + 512 + wid * 64 + cc) = o;
    }
  }
}

DEVI void phase1b(const Params& p, char* shm, int bid, int nb) {
  for (int q = bid; q < 528; q += nb) { __syncthreads(); lru_unit<0>(p, shm, q); }
}

DEVI int fpad(int i) { return i + (i >> 7); }
DEVI void phase2(const Params& p, char* shm, int bid, int nb) {
  const int tid = threadIdx.x, wid = tid >> 6, lane = tid & 63;
  {
    const int gw = bid * 8 + wid;
    if (gw < 64) {
      const int b = gw >> 4, d = (gw >> 3) & 1, ch = (gw & 7) * 64 + lane;
      const f32x2* AGG = (const f32x2*)(p.ws + OFF_AGG);
      float* CARRY = (float*)(p.ws + OFF_CARRY);
      float h = 0.0f;
      for (int s0 = 0; s0 < 132; s0 += 33) {
        f32x2 ab[33];
#pragma unroll
        for (int i = 0; i < 33; ++i) {
          const int s = s0 + i;
          const int j = d == 0 ? s : (s < 4 ? 3 - s : 4 + (131 - s));
          ab[i] = AGG[((size_t)(b * 132 + j) * 2 + d) * 512 + ch];
        }
        __builtin_amdgcn_sched_barrier(0);
#pragma unroll
        for (int i = 0; i < 33; ++i) {
          const int s = s0 + i;
          const int j = d == 0 ? s : (s < 4 ? 3 - s : 4 + (131 - s));
          if (j >= 4) CARRY[((size_t)(b * 128 + (j - 4)) * 2 + d) * 512 + ch] = h;
          h = ab[i][0] * h + ab[i][1];
        }
      }
    }
  }
  f32x2* dt = (f32x2*)shm;
  f32x2* tw = (f32x2*)(shm + 68096);
  {
    const f32x2* TW = (const f32x2*)(p.ws + OFF_TW);
    for (int j = tid; j < 4096; j += NT) tw[fpad(j)] = TW[j];
  }
  h16* GT = (h16*)(p.ws + OFF_GT);
  const float nrm = 0.0013810679320049757f;
  auto dpad = [](int i) -> int { return i + 18 * (i >> 9) + ((i >> 5) & 15); };
  auto twid = [&](int j) -> f32x2 {
    const f32x2 w = tw[fpad(j & 4095)];
    return (j & 4096) ? (f32x2){-w[0], -w[1]} : w;
  };
  for (int u = bid; u < 1024; u += nb) {
    const int b = u >> 8, h = (u >> 5) & 7, m = u & 31;
    const int s0 = m, s1 = m == 0 ? 32 : 64 - m;
    h16* g0 = GT + (size_t)(b * 512 + h * 64 + s0) * 8192;
    h16* g1 = GT + (size_t)(b * 512 + h * 64 + s1) * 8192;
    const float sg = m == 0 ? 1.0f : -1.0f;
    __syncthreads();
#pragma unroll 4
    for (int t = 2 * tid; t < 8192; t += 2 * NT) {
      const h16x2 a0 = *(const h16x2*)(g0 + t), a1 = *(const h16x2*)(g1 + t);
      dt[dpad(t)] = (f32x2){(float)a0[0], sg * (float)a1[0]}; dt[dpad(t + 1)] = (f32x2){(float)a0[1], sg * (float)a1[1]};
    }
    __syncthreads();
#pragma unroll 1
    for (int pass = 0; pass < 3; ++pass) {
      const int lgS = pass == 0 ? 9 : (pass == 1 ? 5 : 1);
      const int S = 1 << lgS;
      const int r = tid & (S - 1), base = ((tid >> lgS) << (lgS + 4)) + r;
      f32x2 x[16];
#pragma unroll
      for (int j = 0; j < 16; ++j) x[j] = dt[dpad(base + (j << lgS))];
      const float c1 = 0.9238795325112867f, s1_ = 0.3826834323650898f, c2 = 0.7071067811865476f;
#define CMULC(v, wr_, wi_) { const float tr = v[0] * (wr_) - v[1] * (wi_), ti = v[0] * (wi_) + v[1] * (wr_); v[0] = tr; v[1] = ti; }
#pragma unroll
      for (int j = 0; j < 8; ++j) { const f32x2 a = x[j], bq = x[j + 8]; x[j] = a + bq; x[j + 8] = a - bq; }
      CMULC(x[9], c1, -s1_) CMULC(x[10], c2, -c2) CMULC(x[11], s1_, -c1) { const f32x2 v = x[12]; x[12] = (f32x2){v[1], -v[0]}; }
      CMULC(x[13], -s1_, -c1) CMULC(x[14], -c2, -c2) CMULC(x[15], -c1, -s1_)
#pragma unroll
      for (int g = 0; g < 16; g += 8)
#pragma unroll
        for (int j = 0; j < 4; ++j) { const f32x2 a = x[g + j], bq = x[g + j + 4]; x[g + j] = a + bq; x[g + j + 4] = a - bq; }
#pragma unroll
      for (int g = 0; g < 16; g += 8) { CMULC(x[g + 5], c2, -c2) { const f32x2 v = x[g + 6]; x[g + 6] = (f32x2){v[1], -v[0]}; } CMULC(x[g + 7], -c2, -c2) }
#pragma unroll
      for (int g = 0; g < 16; g += 4)
#pragma unroll
        for (int j = 0; j < 2; ++j) { const f32x2 a = x[g + j], bq = x[g + j + 2]; x[g + j] = a + bq; x[g + j + 2] = a - bq; }
#pragma unroll
      for (int g = 0; g < 16; g += 4) { const f32x2 v = x[g + 3]; x[g + 3] = (f32x2){v[1], -v[0]}; }
#pragma unroll
      for (int g = 0; g < 16; g += 2) { const f32x2 a = x[g], bq = x[g + 1]; x[g] = a + bq; x[g + 1] = a - bq; }
      const int tsh = 13 - (lgS + 4);
#pragma unroll
      for (int q = 0; q < 16; ++q) {
        const int pos = ((q & 1) << 3) | ((q & 2) << 1) | ((q & 4) >> 1) | ((q & 8) >> 3);
        f32x2 v = x[pos];
        if (q) { const f32x2 w = twid((r * q) << tsh); CMULC(v, w[0], w[1]) }
        dt[dpad(base + (q << lgS))] = v;
      }
#undef CMULC
      __syncthreads();
    }
    auto rdW = [&](int k) -> f32x2 {
      const int pp = ((k & 15) << 9) + (((k >> 4) & 15) << 5) + (((k >> 8) & 15) << 1);
      const f32x2 a = dt[dpad(pp)], bq = dt[dpad(pp + 1)];
      return (k & 4096) ? a - bq : a + bq;
    };
#pragma unroll 2
    for (int k = 2 * tid; k < 8192; k += 2 * NT) {
      float y0[2], y1[2];
#pragma unroll
      for (int u2 = 0; u2 < 2; ++u2) {
        const f32x2 w1 = rdW(k + u2), w2 = rdW((8192 - (k + u2)) & 8191);
        if (m == 0) { y0[u2] = 0.5f * (w1[0] + w2[0]); y1[u2] = 0.5f * (w1[1] + w2[1]); }
        else { y0[u2] = w1[0]; y1[u2] = w2[0]; }
      }
      *(h16x2*)(g0 + k) = (h16x2){(h16)(y0[0] * nrm), (h16)(y0[1] * nrm)};
      *(h16x2*)(g1 + k) = (h16x2){(h16)(y1[0] * nrm), (h16)(y1[1] * nrm)};
    }
  }
}

DEVI void phase3a(const Params& p, char* shm, int bid, int nb) {
  const int tid = threadIdx.x, wid = tid >> 6, lane = tid & 63;
  for (int q = bid; q < 512; q += nb) {
    __syncthreads();
    lru_unit<1>(p, shm, q);
    __syncthreads();
    int tid_o = threadIdx.x; asm volatile("" : "+v"(tid_o));
    const int wid = __builtin_amdgcn_readfirstlane(tid_o >> 6), lane = tid_o & 63;
    const int b = q >> 7, t0 = (q & 127) * 64, tok0 = q * 64;
    const h16* GT = (const h16*)(p.ws + OFF_GT);
    float* yl = (float*)shm + wid * 4160;
    float* ssq_l = (float*)shm + 8 * 4160;
    float ss = 0;
#pragma unroll 32
    for (int m = 0; m < 64; ++m) {
      const float y = (float)GT[(size_t)(b * 512 + wid * 64 + m) * 8192 + t0 + lane];
      yl[m * 65 + lane] = y; ss += y * y;
    }
    ssq_l[wid * 64 + lane] = ss;
    __syncthreads();
    h16* A2 = (h16*)(p.ws + OFF_A2);
    const int mc = (lane & 7) * 8;
    float gg[8];
#pragma unroll
    for (int jj = 0; jj < 8; ++jj) gg[jj] = p.fourier_out_g[wid * 64 + mc + jj];
    for (int i = 0; i < 8; ++i) {
      const int t = (lane >> 3) + 8 * i;
      float tot = 0;
#pragma unroll
      for (int w = 0; w < 8; ++w) tot += ssq_l[w * 64 + t];
      const float rstd = rsqrtf(tot * (1.0f / 512.0f) + 1e-6f);
      h16x8 o;
#pragma unroll
      for (int jj = 0; jj < 8; ++jj) o[jj] = (h16)(yl[(mc + jj) * 65 + t] * rstd * gg[jj]);
      *(h16x8*)(A2 + (size_t)(tok0 + t) * 1024 + wid * 64 + mc) = o;
    }
  }
}

DEVI void phase3b(const Params& p, char* shm, int bid, int nb) {
  const h16* A2 = (const h16*)(p.ws + OFF_A2);
  const h16* WOUT = (const h16*)(p.ws + OFF_WOUT);
  for (int i = 0;; ++i) {
    const long L = (long)i * nb + bid; if (L >= 512) break;
    int pm, pn; tile_order((int)L, 128, 4, pm, pn);
    gemm_tile<2, true>(p, A2, WOUT, pm, pn, shm);
  }
}
DEVI void phase3c(const Params& p, char* shm, int bid, int nb) {
  const h16* H2S = (const h16*)(p.ws + OFF_XS);
  const h16* WSs = (const h16*)(p.ws + OFF_WS);
  for (int i = 0;; ++i) {
    const long L = (long)i * nb + bid; if (L >= 1024) break;
    int pm, pn; tile_order((int)L, 128, 8, pm, pn);
    gemm_tile<3, false>(p, H2S, WSs, pm, pn, shm);
  }
}

#define XB_TMO      128
#define XB_XCNT(j)  (256  + 64 * (j))
#define XB_XSUB(j)  (1280 + 64 * (j))
#define XB_XGEN(j)  (2304 + 64 * (j))
#define XB_TOP      3328
#define XB_TOPGEN   3392
#define XCD_BAR_WORDS 3456
#define XB_SPIN_CAP (1u << 18)
DEVI unsigned xb_ld(unsigned* p)              { return __hip_atomic_load(p, __ATOMIC_RELAXED, __HIP_MEMORY_SCOPE_AGENT); }
DEVI unsigned xb_add(unsigned* p, unsigned v) { return __hip_atomic_fetch_add(p, v, __ATOMIC_RELAXED, __HIP_MEMORY_SCOPE_AGENT); }
DEVI unsigned xb_xcc_id() { return (unsigned)__builtin_amdgcn_s_getreg((3 << 11) | 20) & 0xFu; }
#define XB_SPIN(cond, bar) do { unsigned _sp = 0; while (cond) { __builtin_amdgcn_s_sleep(1); \
    if ((++_sp & 255u) == 0u) { if (xb_ld(&(bar)[XB_TMO])) break; if (_sp > XB_SPIN_CAP) { atomicAdd(&(bar)[XB_TMO], 1u); break; } } } } while (0)
struct XcdBarrier { unsigned* bar; unsigned x; volatile LAS unsigned* st; };
DEVI XcdBarrier xcd_barrier_post(unsigned* bar, volatile LAS unsigned* st) {
  XcdBarrier b; b.bar = bar; b.x = xb_xcc_id(); b.st = st;
  if (threadIdx.x == 0) (void)xb_add(&bar[XB_XCNT(b.x)], 1u);
  return b;
}
DEVI void xcd_barrier_complete(unsigned* bar, unsigned x, unsigned& nloc, unsigned& nx) {
  const unsigned G = gridDim.x * gridDim.y * gridDim.z;
  unsigned sum, cnt, mine, sp = 0u;
  for (;;) {
    sum = 0u; cnt = 0u; mine = 0u;
#pragma unroll
    for (unsigned j = 0; j < 16; ++j) { const unsigned c = xb_ld(&bar[XB_XCNT(j)]); sum += c; cnt += (c > 0u) ? 1u : 0u; mine = (j == x) ? c : mine; }
    if (sum == G) break;
    __builtin_amdgcn_s_sleep(1);
    if ((++sp & 255u) == 0u) { if (xb_ld(&bar[XB_TMO])) break; if (sp > XB_SPIN_CAP) { atomicAdd(&bar[XB_TMO], 1u); break; } }
  }
  nloc = mine > 0u ? mine : 1u; nx = cnt > 0u ? cnt : 1u;
}
DEVI void xcd_barrier(const XcdBarrier& b) {
  asm volatile("s_waitcnt vmcnt(0)" ::: "memory");
  __syncthreads();
  if (threadIdx.x == 0) {
    unsigned* bar = b.bar;
    __builtin_amdgcn_s_waitcnt(0);
    unsigned nloc = b.st[0], nx = b.st[1];
    if (nloc == 0u) { xcd_barrier_complete(bar, b.x, nloc, nx); b.st[0] = nloc; b.st[1] = nx; }
    const unsigned old = xb_add(&bar[XB_XSUB(b.x)], 1u);
    const unsigned gen = old / nloc;
    if (old + 1u == (gen + 1u) * nloc) {
      __builtin_amdgcn_fence(__ATOMIC_RELEASE, "agent");
      asm volatile("s_waitcnt vmcnt(0)" ::: "memory");
      const unsigned og = xb_add(&bar[XB_TOP], 1u);
      const unsigned tg = og / nx;
      if (og + 1u == (tg + 1u) * nx) xb_add(&bar[XB_TOPGEN], 1u);
      else XB_SPIN(xb_ld(&bar[XB_TOPGEN]) == tg, bar);
      __builtin_amdgcn_fence(__ATOMIC_ACQUIRE, "agent");
      xb_add(&bar[XB_XGEN(b.x)], 1u);
      asm volatile("s_waitcnt vmcnt(0)" ::: "memory");
    } else {
      XB_SPIN(xb_ld(&bar[XB_XGEN(b.x)]) == gen, bar);
      __builtin_amdgcn_fence(__ATOMIC_ACQUIRE, "agent");
      asm volatile("s_waitcnt vmcnt(0)" ::: "memory");
    }
  }
  __syncthreads();
}

template <int XM> DEVI unsigned swz_xor(unsigned v) { return (unsigned)__builtin_amdgcn_ds_swizzle((int)v, 0x1F | (XM << 10)); }
template <int K, int J> DEVI void bitonic_step(unsigned (&x)[8], int lane) {
  if constexpr (J < 8) {
#pragma unroll
    for (int r = 0; r < 8; ++r) if ((r & J) == 0) {
      const unsigned a = x[r], b = x[r | J], mn = a < b ? a : b, mx = a < b ? b : a;
      if constexpr (K < 8) { const bool asc = (r & K) == 0; x[r] = asc ? mn : mx; x[r | J] = asc ? mx : mn; }
      else { const bool asc = K >= 512 ? true : ((lane & (K >> 3)) == 0); x[r] = asc ? mn : mx; x[r | J] = asc ? mx : mn; }
    }
  } else {
    constexpr int XL = J >> 3;
    const bool asc = K >= 512 ? true : ((lane & (K >> 3)) == 0);
    const bool lower = (lane & XL) == 0;
    const bool take_min = (asc == lower);
#pragma unroll
    for (int r = 0; r < 8; ++r) {
      unsigned o;
      if constexpr (XL < 32) o = swz_xor<XL>(x[r]); else o = (unsigned)__shfl_xor((int)x[r], 32);
      const unsigned mn = x[r] < o ? x[r] : o, mx = x[r] < o ? o : x[r];
      x[r] = take_min ? mn : mx;
    }
  }
}
template <int K, int J> DEVI void bitonic_merge(unsigned (&x)[8], int lane) {
  bitonic_step<K, J>(x, lane);
  if constexpr (J > 1) bitonic_merge<K, J / 2>(x, lane);
}
template <int K> DEVI void bitonic_sort(unsigned (&x)[8], int lane) {
  if constexpr (K > 2) bitonic_sort<K / 2>(x, lane);
  bitonic_merge<K, K / 2>(x, lane);
}

DEVI void phase3d(const Params& p, char* shm, int bid, int nb, float* const outp) {
  const int tid = threadIdx.x, wid = tid >> 6, lane = tid & 63, grp = lane >> 4, q16 = lane & 15;
  const float* MOD = (const float*)(p.ws + OFF_MOD);
  const float* SSQ2 = (const float*)(p.ws + OFF_SSQ2);
  const unsigned* TOPK = (const unsigned*)(p.ws + OFF_UX);
  const unsigned char* UB8 = (const unsigned char*)(p.ws + OFF_UB);
  const unsigned char* VB8 = (const unsigned char*)(p.ws + OFF_VB);
  const float* SU = (const float*)(p.ws + OFF_UB + 16777216);
  const float* SV = (const float*)(p.ws + OFF_VB + 16777216);
  const h16* X1 = (const h16*)(p.ws + OFF_GXG);
  char* wbase = shm + wid * 7168;
  unsigned* kl = (unsigned*)wbase; float* gl = (float*)(wbase + 2048); float* sl = (float*)(wbase + 4096);
  for (int qd = bid * 8 + wid; qd < 8192; qd += nb * 8) {
    const int tokb = qd * 4;
    const int tok = tokb + grp;
    const float* mod = MOD + (tokb >> 13) * 6144;
    {
      const int q = lane & 31, part = lane >> 5, jt = q >> 3, hd = q & 7, tk = tokb + jt;
      const u32x4* tA = (const u32x4*)(TOPK + ((size_t)tk * 16 + hd * 2 + part) * 16);
      const u32x4* tB = (const u32x4*)(TOPK + ((size_t)tk * 16 + hd * 2 + (1 - part)) * 16);
      unsigned A[16], B[16];
#pragma unroll
      for (int i = 0; i < 4; ++i) { const u32x4 a = tA[i], bq = tB[i];
#pragma unroll
        for (int c = 0; c < 4; ++c) { A[4 * i + c] = a[c]; B[4 * i + c] = bq[c]; } }
      unsigned char* ib = (unsigned char*)(wbase + 6144);
      if (part == 0) {
#pragma unroll
        for (int i = 0; i < 4; ++i) {
          ((unsigned*)ib)[q * 8 + i] = (A[4 * i] & 127u) | ((A[4 * i + 1] & 127u) << 8) | ((A[4 * i + 2] & 127u) << 16) | ((A[4 * i + 3] & 127u) << 24);
          ((unsigned*)ib)[q * 8 + 4 + i] = (B[4 * i] & 127u) | ((B[4 * i + 1] & 127u) << 8) | ((B[4 * i + 2] & 127u) << 16) | ((B[4 * i + 3] & 127u) << 24);
        }
      }
      float va[4], vb[16];
#pragma unroll
      for (int k = 0; k < 4; ++k) va[k] = key2f(A[k] & ~127u);
#pragma unroll
      for (int k = 0; k < 16; ++k) vb[k] = key2f(B[k] & ~127u);
      unsigned Ls[16];
#pragma unroll
      for (int k = 0; k < 16; ++k) Ls[k] = 0u;
#pragma unroll
      for (int a = 0; a < 4; ++a)
#pragma unroll
        for (int bb = a; bb < 16; ++bb) if ((a + 1) * (bb + 1) <= 16) {
          unsigned x = (f2key(va[a] + vb[bb]) & ~511u) | (unsigned)(part << 8) | (unsigned)(a << 4) | (unsigned)bb;
          if (a == bb) x = part ? 0u : x;
#pragma unroll
          for (int k = 0; k < 16; ++k) { const unsigned hi = umax(Ls[k], x); x = Ls[k] < x ? Ls[k] : x; Ls[k] = hi; }
        }
      unsigned C[16];
#pragma unroll
      for (int k = 0; k < 16; ++k) C[k] = umax(Ls[k], (unsigned)__shfl_xor((int)Ls[15 - k], 32));
#pragma unroll
      for (int d = 8; d >= 1; d >>= 1)
#pragma unroll
        for (int k = 0; k < 16; ++k) if ((k & d) == 0) { const unsigned a = C[k], c2 = C[k + d]; C[k] = umax(a, c2); C[k + d] = a < c2 ? a : c2; }
      float ex[16]; float den = 0.0f;
      const float smax = key2f(C[0] & ~511u);
#pragma unroll
      for (int k = 0; k < 16; ++k) { ex[k] = __expf(key2f(C[k] & ~511u) - smax); den += ex[k]; }
      const float rden = 1.0f / den;
      if (part == 0) {
#pragma unroll
        for (int k = 0; k < 16; ++k) {
          const unsigned c = C[k], pp = (c >> 8) & 1u, a = (c >> 4) & 15u, bb = c & 15u;
          const unsigned i1 = pp ? bb : a, i2 = pp ? a : bb;
          const unsigned ex_id = ((unsigned)ib[q * 32 + i1] * 128u + (unsigned)ib[q * 32 + 16 + i2]);
          const int slot = jt * 128 + hd * 16 + k;
          kl[slot] = (ex_id << 9) | (unsigned)slot;
          gl[slot] = ex[k] * rden * SV[ex_id];
          sl[slot] = SU[ex_id];
        }
      }
    }
    unsigned ks[8];
    {
      const u32x4 k0 = *(const u32x4*)(kl + grp * 128 + q16 * 8), k1 = *(const u32x4*)(kl + grp * 128 + q16 * 8 + 4);
#pragma unroll
      for (int c = 0; c < 4; ++c) { ks[c] = k0[c]; ks[4 + c] = k1[c]; }
    }
    bitonic_sort<128>(ks, q16);
    int hq[16]; float sx;
    {
      const f32x4 sq = *(const f32x4*)(SSQ2 + (size_t)tok * 4);
      const float rstd2 = rsqrtf(((sq[0] + sq[1]) + (sq[2] + sq[3])) * (1.0f / 1024.0f) + 1e-6f);
      f32x4 hv[16]; float am = 0.0f;
#pragma unroll
      for (int i = 0; i < 4; ++i) {
        __builtin_amdgcn_sched_barrier(0);
#pragma unroll
        for (int c = 0; c < 4; ++c) {
          const int el = 256 * i + 16 * q16 + 4 * c;
          const h16x4 xh_ = *(const h16x4*)(X1 + (size_t)tok * 1024 + el); const f32x4 xv = {(float)xh_[0], (float)xh_[1], (float)xh_[2], (float)xh_[3]};
          const f32x4 g = *(const f32x4*)(p.norm2_g + el), sc = *(const f32x4*)(mod + 4096 + el), sh = *(const f32x4*)(mod + 3072 + el);
          const f32x4 h = xv * rstd2 * g * (sc + 1.0f) + sh;
          hv[i * 4 + c] = h;
          am = fmaxf(fmaxf(am, fmaxf(fabsf(h[0]), fabsf(h[1]))), fmaxf(fabsf(h[2]), fabsf(h[3])));
        }
      }
      __builtin_amdgcn_sched_barrier(0);
      { unsigned m = __float_as_uint(am); m = umax(m, dpp_u<0xB1>(m)); m = umax(m, dpp_u<0x4E>(m)); m = umax(m, dpp_u<0x141>(m)); m = umax(m, dpp_u<0x140>(m)); am = __uint_as_float(m); }
      const float qs = am > 0.0f ? 127.0f / am : 1.0f;
      sx = am * (1.0f / 127.0f);
#pragma unroll
      for (int k = 0; k < 16; ++k) {
        const int q0 = (int)rintf(hv[k][0] * qs), q1 = (int)rintf(hv[k][1] * qs), q2 = (int)rintf(hv[k][2] * qs), q3 = (int)rintf(hv[k][3] * qs);
        hq[k] = (int)((unsigned)(q0 & 255) | ((unsigned)(q1 & 255) << 8) | ((unsigned)(q2 & 255) << 16) | ((unsigned)(q3 & 255) << 24));
      }
    }
#define KEY_AT(RR, LL) ((unsigned)__shfl((int)ks[RR], (lane & 48) | (LL)))
#define U_LOAD(S, KEYV) { const unsigned key_ = (KEYV); \
      const unsigned char* ub_ = UB8 + (size_t)(key_ >> 9) * 1024 + q16 * 16; \
      _Pragma("unroll") for (int i = 0; i < 4; ++i) UR[S][i] = *(const u32x4*)(ub_ + 256 * i); \
      SUv[S] = sl[key_ & 511u]; GGv[S] = gl[key_ & 511u]; SLv[S] = key_ & 511u; }
#define U_COMPUTE(S) { \
      int a0_ = 0, a1_ = 0, a2_ = 0, a3_ = 0; \
      _Pragma("unroll") for (int i = 0; i < 4; ++i) { \
        a0_ = __builtin_amdgcn_sdot4((int)UR[S][i][0], hq[i * 4 + 0], a0_, false); a1_ = __builtin_amdgcn_sdot4((int)UR[S][i][1], hq[i * 4 + 1], a1_, false); \
        a2_ = __builtin_amdgcn_sdot4((int)UR[S][i][2], hq[i * 4 + 2], a2_, false); a3_ = __builtin_amdgcn_sdot4((int)UR[S][i][3], hq[i * 4 + 3], a3_, false); } \
      const float d = row_sum16((float)((a0_ + a1_) + (a2_ + a3_))) * (SUv[S] * sx); \
      const float w_ = GGv[S] * gelu_tanh_fast(d); \
      if (q16 == 0) gl[SLv[S]] = w_; }
    {
      u32x4 UR[4][4]; float SUv[4], GGv[4]; unsigned SLv[4];
      U_LOAD(0, KEY_AT(0, 0)) U_LOAD(1, KEY_AT(1, 0)) U_LOAD(2, KEY_AT(2, 0))
      unsigned keyn = KEY_AT(3, 0);
#pragma unroll 1
      for (int L = 0; L < 16; ++L) {
        const int Ln = L < 15 ? L + 1 : 15;
#pragma unroll
        for (int r = 0; r < 8; ++r) {
          __builtin_amdgcn_sched_barrier(0);
          U_LOAD((r + 3) & 3, keyn)
          keyn = (r + 4 < 8) ? KEY_AT((r + 4) & 7, L) : KEY_AT((r + 4) & 7, Ln);
          __builtin_amdgcn_sched_barrier(0);
          U_COMPUTE(r & 3)
        }
      }
    }
#undef U_LOAD
#undef U_COMPUTE
    f32x2 acc[32];
#pragma unroll
    for (int i = 0; i < 32; ++i) acc[i] = (f32x2){0.0f, 0.0f};
#define V_LOAD(S, KEYV) { const unsigned key_ = (KEYV); \
      const unsigned char* vb_ = VB8 + (size_t)(key_ >> 9) * 1024 + q16 * 16; \
      _Pragma("unroll") for (int i = 0; i < 4; ++i) VR[S][i] = *(const u32x4*)(vb_ + 256 * i); \
      WWv[S] = gl[key_ & 511u]; }
#define V_COMPUTE(S) { const f32x2 w2 = {WWv[S], WWv[S]}; \
      _Pragma("unroll") for (int i = 0; i < 4; ++i) { \
        _Pragma("unroll") for (int c = 0; c < 4; ++c) { \
          const f32x2 lo = __builtin_amdgcn_cvt_pk_f32_fp8((int)VR[S][i][c], false), hi = __builtin_amdgcn_cvt_pk_f32_fp8((int)VR[S][i][c], true); \
          acc[i * 8 + c * 2] = __builtin_elementwise_fma(w2, lo, acc[i * 8 + c * 2]); acc[i * 8 + c * 2 + 1] = __builtin_elementwise_fma(w2, hi, acc[i * 8 + c * 2 + 1]); } } }
    {
      u32x4 VR[4][4]; float WWv[4];
      V_LOAD(0, KEY_AT(0, 0)) V_LOAD(1, KEY_AT(1, 0)) V_LOAD(2, KEY_AT(2, 0))
      unsigned keyn = KEY_AT(3, 0);
#pragma unroll 1
      for (int L = 0; L < 16; ++L) {
        const int Ln = L < 15 ? L + 1 : 15;
#pragma unroll
        for (int r = 0; r < 8; ++r) {
          __builtin_amdgcn_sched_barrier(0);
          V_LOAD((r + 3) & 3, keyn)
          keyn = (r + 4 < 8) ? KEY_AT((r + 4) & 7, L) : KEY_AT((r + 4) & 7, Ln);
          __builtin_amdgcn_sched_barrier(0);
          V_COMPUTE(r & 3)
        }
      }
    }
#undef V_LOAD
#undef V_COMPUTE
#undef KEY_AT
    {
      f32x4 x2[16]; float ss = 0.0f;
#pragma unroll
      for (int i = 0; i < 4; ++i) {
        __builtin_amdgcn_sched_barrier(0);
#pragma unroll
        for (int c = 0; c < 4; ++c) {
          const int el = 256 * i + 16 * q16 + 4 * c;
          const h16x4 xh_ = *(const h16x4*)(X1 + (size_t)tok * 1024 + el); const f32x4 xv = {(float)xh_[0], (float)xh_[1], (float)xh_[2], (float)xh_[3]};
          const f32x4 g2 = *(const f32x4*)(mod + 5120 + el);
          const f32x4 pr = {acc[i * 8 + c * 2][0], acc[i * 8 + c * 2][1], acc[i * 8 + c * 2 + 1][0], acc[i * 8 + c * 2 + 1][1]};
          const f32x4 v = xv + g2 * pr;
          x2[i * 4 + c] = v;
          ss += (v[0] * v[0] + v[1] * v[1]) + (v[2] * v[2] + v[3] * v[3]);
        }
      }
      __builtin_amdgcn_sched_barrier(0);
      ss = row_sum16(ss);
      const float rstd = rsqrtf(ss * (1.0f / 1024.0f) + 1e-6f);
#pragma unroll
      for (int i = 0; i < 4; ++i)
#pragma unroll
        for (int c = 0; c < 4; ++c) {
          const int el = 256 * i + 16 * q16 + 4 * c;
          *(f32x4*)(outp + (size_t)tok * 1024 + el) = x2[i * 4 + c] * rstd * *(const f32x4*)(p.final_norm_g + el);
        }
    }
  }
}


__global__ void __launch_bounds__(NT) fwd_megakernel(Params p) {
  extern __shared__ __attribute__((aligned(16))) char shm[];
  cg::grid_group grid = cg::this_grid();
  const int bid = blockIdx.x, nb = gridDim.x;
  volatile LAS unsigned* xst = (volatile LAS unsigned*)(shm + LDS_USED);
  if (threadIdx.x < 4) xst[threadIdx.x] = 0u;
  __syncthreads();
  const XcdBarrier xb = xcd_barrier_post((unsigned*)(p.ws + OFF_BAR), xst);
#define GSYNC() xcd_barrier(xb)
  grid.sync();
  phase0a(p, shm, bid, nb); GSYNC();
  phase0b(p, shm, bid, nb); GSYNC();
  phase1(p, shm, bid, nb);  GSYNC();
  phase1b(p, shm, bid, nb); GSYNC();
  phase2(p, shm, bid, nb);  GSYNC();
  phase3a(p, shm, bid, nb); GSYNC();
  phase3b(p, shm, bid, nb); GSYNC();
  phase3c(p, shm, bid, nb); GSYNC();
  phase3d(p, shm, bid, nb, p.out);
}

extern "C" void kernel_launch(void* const* d_in, const int* in_sizes, int n_in, void* d_out, int out_size, void* d_ws, size_t ws_size, hipStream_t stream) {
  if (ws_size < WS_NEED) { fprintf(stderr, "workspace too small: %zu < %zu\n", ws_size, (size_t)WS_NEED); return; }
  Params p{};
  const float** pp = (const float**)&p;
  for (int i = 0; i < 24; ++i) pp[i] = (const float*)d_in[i];
  p.out = (float*)d_out; p.ws = (char*)d_ws;
  static int grid_blocks = 0;
  if (!grid_blocks) {
    hipFuncSetAttribute((const void*)fwd_megakernel, hipFuncAttributeMaxDynamicSharedMemorySize, LDS_BYTES);
    int dev = 0, cus = 0, per_cu = 0;
    hipGetDevice(&dev);
    hipDeviceGetAttribute(&cus, hipDeviceAttributeMultiprocessorCount, dev);
    hipOccupancyMaxActiveBlocksPerMultiprocessor(&per_cu, fwd_megakernel, NT, LDS_BYTES);
    if (per_cu > 1) per_cu = 1;
    grid_blocks = cus * per_cu;
  }
  (void)hipMemsetAsync((char*)d_ws + OFF_BAR, 0, 16384, stream);
  void* args[] = {&p};
  hipError_t e = hipLaunchCooperativeKernel((void*)fwd_megakernel, dim3(grid_blocks), dim3(NT), args, LDS_BYTES, stream);
  if (e != hipSuccess) fprintf(stderr, "cooperative launch failed: %s (grid %d)\n", hipGetErrorString(e), grid_blocks);
}
```

```cpp
#include <hip/hip_runtime.h>
#include <hip/hip_cooperative_groups.h>
#include <cstdio>
#include <cstdint>
namespace cg = cooperative_groups;

typedef _Float16 h16;
typedef _Float16 h16x2 __attribute__((ext_vector_type(2)));
typedef _Float16 h16x4 __attribute__((ext_vector_type(4)));
typedef _Float16 h16x8 __attribute__((ext_vector_type(8)));
typedef float f32x4 __attribute__((ext_vector_type(4)));
typedef float f32x2 __attribute__((ext_vector_type(2)));
typedef unsigned u32x4 __attribute__((ext_vector_type(4)));

#define DEVI __device__ __forceinline__
constexpr int NT = 512;
constexpr int LDS_USED = 151552;
constexpr int LDS_BYTES = LDS_USED + 16;

struct Params {
  const float *x, *c, *ctx, *c_ctx, *w_mod, *b_mod, *norm1_g, *w_in, *conv_w, *conv_b,
      *lru_w_a, *lru_b_a, *lru_w_x, *lru_b_x, *lru_lambda, *fourier_out_g, *lru_out_g,
      *w_out, *norm2_g, *peer_w_q, *peer_sub_keys, *peer_u, *peer_v, *final_norm_g;
  float* out;
  char* ws;
};

constexpr size_t OFF_MOD   = 0;
constexpr size_t OFF_TW    = OFF_MOD   + 122880;
constexpr size_t OFF_BIAS1 = OFF_TW    + 32768;
constexpr size_t OFF_BIAS3 = OFF_BIAS1 + 30720;
constexpr size_t OFF_RSTD1 = OFF_BIAS3 + 32768;
constexpr size_t OFF_SSQ2  = OFF_RSTD1 + 135168;
constexpr size_t OFF_AGG   = OFF_SSQ2  + 524288;
constexpr size_t OFF_CARRY = OFF_AGG   + 4325376;
constexpr size_t OFF_SP    = OFF_CARRY + 2097152;
constexpr size_t OFF_WF    = OFF_SP    + 4096;
constexpr size_t OFF_WIN   = OFF_WF    + 262144;
constexpr size_t OFF_WOUT  = OFF_WIN   + 3145728;
constexpr size_t OFF_WS    = OFF_WOUT  + 2097152;
constexpr size_t OFF_UB    = OFF_WS    + 4194304;
constexpr size_t OFF_VB    = OFF_UB    + 33554432;
constexpr size_t OFF_XS    = OFF_VB    + 33554432;
constexpr size_t OFF_GT    = OFF_XS    + 69206016;
constexpr size_t OFF_UX    = OFF_GT    + 67108864;
constexpr size_t OFF_GXG   = OFF_UX    + 69206016;
constexpr size_t OFF_HB    = OFF_GXG   + 67108864;
constexpr size_t OFF_A2    = OFF_HB    + 67108864;
constexpr size_t OFF_BAR   = OFF_A2    + 67108864;
constexpr size_t WS_NEED   = OFF_BAR   + 16384;

template <int CTRL> DEVI float dpp_f(float v) {
  return __builtin_bit_cast(float, __builtin_amdgcn_update_dpp(0, __builtin_bit_cast(int, v), CTRL, 0xf, 0xf, false));
}
template <int CTRL> DEVI unsigned dpp_u(unsigned v) {
  return (unsigned)__builtin_amdgcn_update_dpp(0, (int)v, CTRL, 0xf, 0xf, false);
}
DEVI float row_sum16(float v) {
  v += dpp_f<0xB1>(v); v += dpp_f<0x4E>(v); v += dpp_f<0x141>(v); v += dpp_f<0x140>(v); return v;
}
DEVI float rl_f(float v, int l) { return __builtin_bit_cast(float, __builtin_amdgcn_readlane(__builtin_bit_cast(int, v), l)); }
DEVI float wave_sum(float v) {
  v = row_sum16(v);
  return (rl_f(v, 0) + rl_f(v, 16)) + (rl_f(v, 32) + rl_f(v, 48));
}
DEVI unsigned umax(unsigned a, unsigned b) { return a > b ? a : b; }
DEVI unsigned wave_max_u(unsigned v) {
  v = umax(v, dpp_u<0xB1>(v)); v = umax(v, dpp_u<0x4E>(v)); v = umax(v, dpp_u<0x141>(v)); v = umax(v, dpp_u<0x140>(v));
  unsigned a = (unsigned)__builtin_amdgcn_readlane((int)v, 0), b = (unsigned)__builtin_amdgcn_readlane((int)v, 16);
  unsigned c = (unsigned)__builtin_amdgcn_readlane((int)v, 32), d = (unsigned)__builtin_amdgcn_readlane((int)v, 48);
  return umax(umax(a, b), umax(c, d));
}
DEVI float gelu_tanh(float x) {
  float u = 0.7978845608028654f * (x + 0.044715f * x * x * x);
  float e = __expf(2.0f * u);
  float t = 1.0f - 2.0f / (1.0f + e);
  return 0.5f * x * (1.0f + t);
}
DEVI float gelu_tanh_fast(float x) {
  const float u = 0.7978845608028654f * (x + 0.044715f * x * x * x);
  const float e = __builtin_amdgcn_exp2f(u * 2.8853900817779268f);
  const float t = 1.0f - 2.0f * __builtin_amdgcn_rcpf(1.0f + e);
  return 0.5f * x * (1.0f + t);
}
DEVI float sigmoidf_(float x) { return 1.0f / (1.0f + __expf(-x)); }
DEVI unsigned f2key(float f) { unsigned u = __float_as_uint(f); return (u & 0x80000000u) ? ~u : (u | 0x80000000u); }
DEVI float key2f(unsigned k) { unsigned u = (k & 0x80000000u) ? (k & 0x7fffffffu) : ~k; return __uint_as_float(u); }

constexpr int BM = 256, BK = 64, HALF = 128, HT = HALF * BK, KD = 1024;
DEVI int lds_byte(int r, int c) {
  int st = (r >> 4) * 2 + (c >> 5), rr = r & 15, cc = c & 31, ob = rr * 64 + cc * 2;
  return st * 1024 + (ob ^ (((ob >> 9) & 1) << 5));
}
DEVI void stage_rc(int b, int& R, int& C) {
  int st = b / 1024, sb = b % 1024, swz = sb ^ (((sb >> 9) & 1) << 5);
  R = (st >> 1) * 16 + swz / 64; C = (st & 1) * 32 + (swz % 64) / 2;
}
DEVI void tile_order(int L, int nM, int nN, int& pm, int& pn) {
  int nwg = nM * nN, wgid = L;
  { int q = nwg / 8, r = nwg % 8, xcd = wgid % 8, off = wgid / 8; wgid = (xcd < r ? xcd * (q + 1) : r * (q + 1) + (xcd - r) * q) + off; }
  int nig = 8 * nN, gid = wgid / nig, fm = gid * 8, gsz = (nM - fm) < 8 ? (nM - fm) : 8;
  pm = fm + ((wgid % nig) % gsz); pn = (wgid % nig) / gsz;
}

#define LAS __attribute__((address_space(3)))
constexpr int HTB = HALF * BK * 2;
template <int EPI, bool TRANS>
DEVI void gemm_tile(const Params& p, const h16* __restrict__ A, const h16* __restrict__ Bt, int pm, int pn, char* shmc) {
  LAS unsigned char* lds = (LAS unsigned char*)shmc;
  int tid_k = threadIdx.x; asm volatile("" : "+v"(tid_k));
  const int tid = tid_k;
  const int brow = pm * BM, bcol = pn * BM;
  const int wid = tid >> 6, lane = tid & 63, wr = wid >> 2, wc = wid & 3, fr = lane & 15, fq = lane >> 4;
  unsigned voff[2];
#pragma unroll
  for (int i = 0; i < 2; ++i) { int R, C; stage_rc(tid * 16 + i * 8192, R, C); voff[i] = (unsigned)(R * KD + C) * 2u; }
  constexpr size_t kstep = (size_t)(BK * 2), hstep = (size_t)HALF * KD * 2;
  const unsigned ldsw = (unsigned)wid * 1024u;
  const int aoff = lds_byte(wr * 64 + fr, fq * 8), boff = lds_byte(wc * 32 + fr, fq * 8);
  const char* cA = (const char*)A + (size_t)brow * KD * 2;
  const char* cB = (const char*)Bt + (size_t)bcol * KD * 2;
#define SA(b, h) (((b) * 2 + (h)) * HTB)
#define SB(b, h) ((4 + (b) * 2 + (h)) * HTB)
#define STAGE(bufoff, gbase) do { _Pragma("unroll") for (int _i = 0; _i < 2; ++_i) \
    __builtin_amdgcn_global_load_lds((const unsigned*)((const char*)(gbase) + voff[_i]), (LAS unsigned*)(lds + (bufoff) + ldsw + _i * 8192), 16, 0, 0); } while (0)
#define LDA(dst, b, h) do { _Pragma("unroll") for (int m = 0; m < 4; ++m) _Pragma("unroll") for (int k = 0; k < 2; ++k) dst[m][k] = *(const LAS h16x8*)(lds + SA(b, h) + aoff + m * 2048 + k * 1024); } while (0)
#define LDB(dst, b, h) do { _Pragma("unroll") for (int n = 0; n < 2; ++n) _Pragma("unroll") for (int k = 0; k < 2; ++k) dst[n][k] = *(const LAS h16x8*)(lds + SB(b, h) + boff + n * 2048 + k * 1024); } while (0)
#define MMA(ai, bj, At_, Bt_) do { __builtin_amdgcn_s_setprio(1); _Pragma("unroll") for (int m = 0; m < 4; ++m) _Pragma("unroll") for (int n = 0; n < 2; ++n) _Pragma("unroll") for (int k = 0; k < 2; ++k) \
      acc[ai][bj][m][n] = TRANS ? __builtin_amdgcn_mfma_f32_16x16x32_f16(Bt_[n][k], At_[m][k], acc[ai][bj][m][n], 0, 0, 0) \
                                : __builtin_amdgcn_mfma_f32_16x16x32_f16(At_[m][k], Bt_[n][k], acc[ai][bj][m][n], 0, 0, 0); \
    __builtin_amdgcn_s_setprio(0); } while (0)
#define WAIT_V(n) asm volatile("s_waitcnt vmcnt(" #n ")" ::: "memory")
#define WAIT_L(n) asm volatile("s_waitcnt lgkmcnt(" #n ")" ::: "memory")
#define BAR __builtin_amdgcn_s_barrier()
#define SCHED __builtin_amdgcn_sched_barrier(0)
  f32x4 acc[2][2][4][2];
#pragma unroll
  for (int a = 0; a < 2; ++a)
#pragma unroll
    for (int b = 0; b < 2; ++b)
#pragma unroll
      for (int m = 0; m < 4; ++m)
#pragma unroll
        for (int n = 0; n < 2; ++n) acc[a][b][m][n] = (f32x4){0.f, 0.f, 0.f, 0.f};
  h16x8 At[4][2], B0[2][2], B1[2][2];
  constexpr int nt = KD / BK;
  STAGE(SB(0, 0), cB); STAGE(SA(0, 0), cA); STAGE(SB(0, 1), cB + hstep); STAGE(SA(0, 1), cA + hstep);
  if (wr == 1) BAR;
  WAIT_V(4); BAR;
  STAGE(SB(1, 0), cB + kstep); STAGE(SA(1, 0), cA + kstep); STAGE(SB(1, 1), cB + hstep + kstep);
  WAIT_V(6); BAR;
#pragma unroll 1
  for (int t = 0; t < nt - 2; t += 2) {
    const char* a1 = cA + (size_t)(t + 1) * kstep;
    const char* a2 = cA + (size_t)(t + 2) * kstep; const char* b2 = cB + (size_t)(t + 2) * kstep;
    const char* a3 = a2 + kstep; const char* b3 = b2 + kstep;
    LDB(B0, 0, 0); SCHED; LDA(At, 0, 0); STAGE(SA(1, 1), a1 + hstep);
    WAIT_L(8); BAR; WAIT_L(0); MMA(0, 0, At, B0); BAR; SCHED;
    LDB(B1, 0, 1); STAGE(SB(0, 0), b2);
    BAR; WAIT_L(0); MMA(0, 1, At, B1); BAR;
    LDA(At, 0, 1); STAGE(SA(0, 0), a2);
    BAR; WAIT_L(0); MMA(1, 0, At, B0); BAR; SCHED;
    STAGE(SB(0, 1), b2 + hstep);
    WAIT_V(6); BAR; MMA(1, 1, At, B1); BAR;
    LDB(B0, 1, 0); SCHED; LDA(At, 1, 0); STAGE(SA(0, 1), a2 + hstep);
    WAIT_L(8); BAR; WAIT_L(0); MMA(0, 0, At, B0); BAR; SCHED;
    LDB(B1, 1, 1); STAGE(SB(1, 0), b3);
    BAR; WAIT_L(0); MMA(0, 1, At, B1); BAR;
    LDA(At, 1, 1); STAGE(SA(1, 0), a3);
    BAR; WAIT_L(0); MMA(1, 0, At, B0); BAR; SCHED;
    STAGE(SB(1, 1), b3 + hstep);
    WAIT_V(6); BAR; MMA(1, 1, At, B1); BAR;
  }
  { LDB(B0, 0, 0); LDA(At, 0, 0); STAGE(SA(1, 1), cA + (size_t)(nt - 1) * kstep + hstep);
    BAR; WAIT_L(0); MMA(0, 0, At, B0); BAR;
    LDB(B1, 0, 1); BAR; WAIT_L(0); MMA(0, 1, At, B1); BAR;
    LDA(At, 0, 1); WAIT_V(4); BAR; WAIT_L(0); MMA(1, 0, At, B0); MMA(1, 1, At, B1); BAR; }
  { LDB(B0, 1, 0); LDA(At, 1, 0); WAIT_V(2); BAR; WAIT_L(0); MMA(0, 0, At, B0); BAR;
    LDB(B1, 1, 1); WAIT_V(0); BAR; WAIT_L(0); MMA(0, 1, At, B1); BAR;
    LDA(At, 1, 1); BAR; WAIT_L(0); MMA(1, 0, At, B0); MMA(1, 1, At, B1); BAR; }
  if (wr == 0) BAR;
#undef SA
#undef SB
#undef STAGE
#undef LDA
#undef LDB
#undef MMA
  int tid_e = threadIdx.x; asm volatile("" : "+v"(tid_e));
  {
  const int tid = tid_e, wid = tid >> 6, lane = tid & 63, wr = wid >> 2, wc = wid & 3, fr = lane & 15, fq = lane >> 4;
  (void)lane; (void)wr; (void)wc; (void)fr; (void)fq;
  if constexpr (EPI == 1) {
    const float* RSTD1 = (const float*)(p.ws + OFF_RSTD1);
    const float* BIAS1 = (const float*)(p.ws + OFF_BIAS1);
    const int bb = brow < 32768 ? (brow >> 13) : 4;
    if constexpr (!TRANS) {
      h16* GT = (h16*)(p.ws + OFF_GT);
#pragma unroll
      for (int ai = 0; ai < 2; ++ai)
#pragma unroll
        for (int m = 0; m < 4; ++m) {
          const int row0 = brow + ai * 128 + wr * 64 + m * 16 + fq * 4;
          const f32x4 rs = *(const f32x4*)(RSTD1 + row0);
#pragma unroll
          for (int bj = 0; bj < 2; ++bj)
#pragma unroll
            for (int n = 0; n < 2; ++n) {
              const int col = bcol + bj * 128 + wc * 32 + n * 16 + fr;
              const float bias = BIAS1[bb * 1536 + col];
              const f32x4 gv = acc[ai][bj][m][n] * rs + bias;
              *(h16x4*)(GT + ((size_t)(bb * 512 + col) * 8192 + (row0 & 8191))) = (h16x4){(h16)gv[0], (h16)gv[1], (h16)gv[2], (h16)gv[3]};
            }
        }
    } else {
      h16* UX = (h16*)(p.ws + OFF_UX);
      h16* GXG = (h16*)(p.ws + OFF_GXG);
#pragma unroll
      for (int ai = 0; ai < 2; ++ai)
#pragma unroll
        for (int m = 0; m < 4; ++m) {
          const int row = brow + ai * 128 + wr * 64 + m * 16 + fr;
          const float rs = RSTD1[row];
#pragma unroll
          for (int bj = 0; bj < 2; ++bj)
#pragma unroll
            for (int n = 0; n < 2; ++n) {
              const int col0 = bcol + bj * 128 + wc * 32 + n * 16 + fq * 4;
              const f32x4 bias = *(const f32x4*)(BIAS1 + bb * 1536 + col0);
              f32x4 v = acc[ai][bj][m][n] * rs + bias;
              if (pn < 4) *(h16x4*)(UX + (size_t)row * 512 + (col0 - 512)) = (h16x4){(h16)v[0], (h16)v[1], (h16)v[2], (h16)v[3]};
              else { v[0] = gelu_tanh(v[0]); v[1] = gelu_tanh(v[1]); v[2] = gelu_tanh(v[2]); v[3] = gelu_tanh(v[3]); *(h16x4*)(GXG + (size_t)row * 512 + (col0 - 1024)) = (h16x4){(h16)v[0], (h16)v[1], (h16)v[2], (h16)v[3]}; }
            }
        }
    }
  } else if constexpr (EPI == 2) {
    static_assert(EPI != 2 || TRANS, "EPI 2 uses transposed accumulators");
    const float* MOD = (const float*)(p.ws + OFF_MOD);
    float* SSQ2 = (float*)(p.ws + OFF_SSQ2);
    h16* H2S = (h16*)(p.ws + OFF_XS);
    h16* X1 = (h16*)(p.ws + OFF_GXG);
    float* red = (float*)shmc;
    const int b = brow >> 13;
    f32x4 g1v[2][2], gsv[2][2];
#pragma unroll
    for (int bj = 0; bj < 2; ++bj)
#pragma unroll
      for (int n = 0; n < 2; ++n) {
        const int col0 = bcol + bj * 128 + wc * 32 + n * 16 + fq * 4;
        g1v[bj][n] = *(const f32x4*)(MOD + b * 6144 + 2048 + col0);
        gsv[bj][n] = *(const f32x4*)(p.norm2_g + col0) * (*(const f32x4*)(MOD + b * 6144 + 4096 + col0) + 1.0f);
      }
#pragma unroll
    for (int am = 0; am < 4; ++am) {
      const int ai = am >> 1, m0 = (am & 1) * 2;
      f32x4 xv[2][2][2];
#pragma unroll
      for (int mm = 0; mm < 2; ++mm)
#pragma unroll
        for (int bj = 0; bj < 2; ++bj)
#pragma unroll
          for (int n = 0; n < 2; ++n)
            xv[mm][bj][n] = *(const f32x4*)(p.x + (size_t)(brow + ai * 128 + wr * 64 + (m0 + mm) * 16 + fr) * 1024 + bcol + bj * 128 + wc * 32 + n * 16 + fq * 4);
      __builtin_amdgcn_sched_barrier(0);
#pragma unroll
      for (int mm = 0; mm < 2; ++mm) {
        const int m = m0 + mm;
        const int row = brow + ai * 128 + wr * 64 + m * 16 + fr;
        float ss = 0.0f;
#pragma unroll
        for (int bj = 0; bj < 2; ++bj)
#pragma unroll
          for (int n = 0; n < 2; ++n) {
            const int col0 = bcol + bj * 128 + wc * 32 + n * 16 + fq * 4;
            const size_t o = (size_t)row * 1024 + col0;
            const f32x4 x1 = xv[mm][bj][n] + g1v[bj][n] * acc[ai][bj][m][n];
            const f32x4 hh = x1 * gsv[bj][n];
            *(h16x4*)(X1 + o) = (h16x4){(h16)x1[0], (h16)x1[1], (h16)x1[2], (h16)x1[3]};
            *(h16x4*)(H2S + o) = (h16x4){(h16)hh[0], (h16)hh[1], (h16)hh[2], (h16)hh[3]};
            ss += (x1[0] * x1[0] + x1[1] * x1[1]) + (x1[2] * x1[2] + x1[3] * x1[3]);
          }
        ss += __shfl_xor(ss, 16); ss += __shfl_xor(ss, 32);
        if (fq == 0) red[wc * 256 + ai * 128 + wr * 64 + m * 16 + fr] = ss;
      }
    }
    __syncthreads();
    if (tid < 256) {
      const int r = tid;
      SSQ2[(size_t)(brow + r) * 4 + pn] = (red[r] + red[256 + r]) + (red[512 + r] + red[768 + r]);
    }
  } else if constexpr (EPI == 3) {
    const float* SSQ2 = (const float*)(p.ws + OFF_SSQ2);
    const float* BIAS3 = (const float*)(p.ws + OFF_BIAS3);
    unsigned* TOPK = (unsigned*)(p.ws + OFF_UX);
    float* sc = (float*)shmc;
    float* rstd_l = (float*)(shmc + 139264);
    const int b = brow >> 13;
    if (tid < 256) {
      const f32x4 q = *(const f32x4*)(SSQ2 + (size_t)(brow + tid) * 4);
      rstd_l[tid] = rsqrtf(((q[0] + q[1]) + (q[2] + q[3])) * (1.0f / 1024.0f) + 1e-6f);
    }
#pragma unroll
    for (int bj = 0; bj < 2; ++bj) {
      __syncthreads();
#pragma unroll
      for (int ai = 0; ai < 2; ++ai)
#pragma unroll
        for (int m = 0; m < 4; ++m) {
          const int r0 = ai * 128 + wr * 64 + m * 16 + fq * 4;
          const f32x4 rstd = *(const f32x4*)(rstd_l + r0);
#pragma unroll
          for (int n = 0; n < 2; ++n) {
            const int cl = wc * 32 + n * 16 + fr;
            const float bias = BIAS3[b * 2048 + bcol + bj * 128 + cl];
            const int pc = cl + 4 * (cl >> 6);
#pragma unroll
            for (int j = 0; j < 4; ++j) sc[(r0 + j) * 136 + pc] = acc[ai][bj][m][n][j] * rstd[j] + bias;
          }
        }
      __syncthreads();
      {
        const int row = tid >> 1, hf = tid & 1;
        const float* rp = sc + row * 136 + hf * 68;
        unsigned Lq[4][16];
#pragma unroll
        for (int c = 0; c < 4; ++c)
#pragma unroll
          for (int k = 0; k < 16; ++k) Lq[c][k] = 0u;
#pragma unroll
        for (int i4 = 0; i4 < 4; ++i4) {
          f32x4 v[4];
#pragma unroll
          for (int c = 0; c < 4; ++c) v[c] = *(const f32x4*)(rp + (c * 4 + i4) * 4);
#pragma unroll
          for (int j = 0; j < 4; ++j)
#pragma unroll
            for (int c = 0; c < 4; ++c) {
              unsigned x = (f2key(v[c][j]) & ~127u) | (unsigned)(hf * 64 + (c * 4 + i4) * 4 + j);
#pragma unroll
              for (int k = 0; k < 16; ++k) { const unsigned hi = umax(Lq[c][k], x); x = Lq[c][k] < x ? Lq[c][k] : x; Lq[c][k] = hi; }
            }
        }
        auto merge16 = [](unsigned (&A)[16], const unsigned (&B)[16]) {
#pragma unroll
          for (int k = 0; k < 16; ++k) A[k] = umax(A[k], B[15 - k]);
#pragma unroll
          for (int d = 8; d >= 1; d >>= 1)
#pragma unroll
            for (int k = 0; k < 16; ++k) if ((k & d) == 0) { const unsigned a = A[k], c2 = A[k + d]; A[k] = umax(a, c2); A[k + d] = a < c2 ? a : c2; }
        };
        merge16(Lq[0], Lq[1]); merge16(Lq[2], Lq[3]); merge16(Lq[0], Lq[2]);
        unsigned (&L)[16] = Lq[0];
        unsigned C[16];
#pragma unroll
        for (int k = 0; k < 16; ++k) C[k] = umax(L[k], dpp_u<0xB1>(L[15 - k]));
#pragma unroll
        for (int d = 8; d >= 1; d >>= 1)
#pragma unroll
          for (int k = 0; k < 16; ++k) if ((k & d) == 0) { const unsigned a = C[k], c2 = C[k + d]; C[k] = umax(a, c2); C[k + d] = a < c2 ? a : c2; }
        unsigned* dst = TOPK + ((size_t)(brow + row) * 16 + (pn * 2 + bj)) * 16;
        if (hf == 0) { *(u32x4*)dst = (u32x4){C[0], C[1], C[2], C[3]}; *(u32x4*)(dst + 4) = (u32x4){C[4], C[5], C[6], C[7]}; }
        else { *(u32x4*)(dst + 8) = (u32x4){C[8], C[9], C[10], C[11]}; *(u32x4*)(dst + 12) = (u32x4){C[12], C[13], C[14], C[15]}; }
      }
    }
  }
  }
  __syncthreads();
}

DEVI void phase0a(const Params& p, char* shm, int bid, int nb) {
  const int tid = threadIdx.x;
  float* MOD = (float*)(p.ws + OFF_MOD);
  h16* WIN = (h16*)(p.ws + OFF_WIN);
  h16* WOUT = (h16*)(p.ws + OFF_WOUT);
  h16* WSs = (h16*)(p.ws + OFF_WS);
  for (int u = bid; u < 1089; u += nb) {
    __syncthreads();
    if (u < 192) {
      float* s = (float*)shm; float* red = s + 5120;
      for (int i = tid; i < 5120; i += NT) { const int v = i >> 10, k = i & 1023; const float xv = v < 4 ? p.c[v * 1024 + k] : p.c_ctx[k]; s[i] = xv / (1.0f + expf(-xv)); }
      __syncthreads();
      const int cl = tid & 31, kg = tid >> 5, n = u * 32 + cl;
      float a0 = 0, a1 = 0, a2 = 0, a3 = 0, a4 = 0;
      for (int k = kg; k < 1024; k += 16) { const float w = p.w_mod[(size_t)k * 6144 + n]; a0 += s[k] * w; a1 += s[1024 + k] * w; a2 += s[2048 + k] * w; a3 += s[3072 + k] * w; a4 += s[4096 + k] * w; }
      float* rr = red + (kg * 32 + cl) * 5; rr[0] = a0; rr[1] = a1; rr[2] = a2; rr[3] = a3; rr[4] = a4;
      __syncthreads();
      if (tid < 160) { const int v = tid >> 5, c2 = tid & 31; float sum = 0; for (int g = 0; g < 16; ++g) sum += red[(g * 32 + c2) * 5 + v]; MOD[v * 6144 + u * 32 + c2] = sum + p.b_mod[u * 32 + c2]; }
    } else if (u < 320) {
      const int uu = u - 192, h = uu >> 4, k0 = (uu & 15) * 64;
      float* wt = (float*)shm; float* bs = wt + 64 * 65;
      for (int i = tid; i < 4096; i += NT) {
        const int kk = i >> 6, j = i & 63;
        wt[kk * 65 + j] = p.w_in[(size_t)(k0 + kk) * 1536 + h * 64 + j];
        const int pp = kk, mf = pp <= 32 ? pp : 64 - pp; const float ang = (float)((mf * j) & 63) * (1.0f / 32.0f);
        bs[i] = pp <= 32 ? cospif(ang) : sinpif(ang);
      }
      __syncthreads();
      for (int o = tid; o < 4096; o += NT) {
        const int kk = o & 63, pp = o >> 6; float sum = 0;
#pragma unroll 8
        for (int j = 0; j < 64; ++j) sum += wt[kk * 65 + j] * bs[pp * 64 + j];
        WIN[(size_t)(h * 64 + pp) * 1024 + k0 + kk] = (h16)sum;
      }
    } else if (u < 832) {
      const bool isout = u >= 576; const int uu = isout ? u - 576 : u - 320;
      const int n0 = (uu >> 4) * 64 + (isout ? 0 : 512), k0 = (uu & 15) * 64;
      const float* src = isout ? p.w_out : p.w_in; const int ld = isout ? 1024 : 1536;
      h16* dst = isout ? WOUT : WIN;
      float* t = (float*)shm;
      for (int i = tid; i < 4096; i += NT) { const int kk = i >> 6, nn = i & 63; t[kk * 65 + nn] = src[(size_t)(k0 + kk) * ld + n0 + nn]; }
      __syncthreads();
      for (int o = tid; o < 4096; o += NT) { const int nn = o >> 6, kk = o & 63; dst[(size_t)(n0 + nn) * 1024 + k0 + kk] = (h16)t[kk * 65 + nn]; }
    } else if (u < 1088) {
      const int uu = u - 832, g = uu >> 4, k0 = (uu & 15) * 64;
      float* q = (float*)shm; float* ky = q + 64 * 129;
      for (int i = tid; i < 64 * 128; i += NT) { const int kk = i >> 7, d = i & 127; q[kk * 129 + d] = p.peer_w_q[(size_t)(k0 + kk) * 2048 + g * 128 + d]; }
      for (int i = tid; i < 128 * 128; i += NT) { const int key = i >> 7, d = i & 127; ky[key * 129 + d] = p.peer_sub_keys[(size_t)(g * 128 + key) * 128 + d]; }
      __syncthreads();
      const int tx = tid & 15, ty = tid >> 4;
      float a[4][4] = {};
      for (int d = 0; d < 128; ++d) {
        float qv[4], kv[4];
#pragma unroll
        for (int i = 0; i < 4; ++i) { qv[i] = q[(tx * 4 + i) * 129 + d]; kv[i] = ky[(ty * 4 + i) * 129 + d]; }
#pragma unroll
        for (int ki = 0; ki < 4; ++ki)
#pragma unroll
          for (int qi = 0; qi < 4; ++qi) a[ki][qi] += kv[ki] * qv[qi];
      }
#pragma unroll
      for (int ki = 0; ki < 4; ++ki) {
        h16x4 o = {(h16)a[ki][0], (h16)a[ki][1], (h16)a[ki][2], (h16)a[ki][3]};
        *(h16x4*)(WSs + (size_t)(g * 128 + ty * 4 + ki) * 1024 + k0 + tx * 4) = o;
      }
    } else {
      f32x2* TW = (f32x2*)(p.ws + OFF_TW);
      for (int j = tid; j < 4096; j += NT) { float s, c; sincospif((float)j * (1.0f / 4096.0f), &s, &c); TW[j] = (f32x2){c, -s}; }
    }
  }
  {
    h16* WF = (h16*)(p.ws + OFF_WF); float* SP = (float*)(p.ws + OFF_SP);
    for (int i = bid * NT + tid; i < 131072; i += nb * NT) {
      const int j = i & 7, ln = (i >> 3) & 63, fragi = i >> 9;
      const int ks = fragi & 3, mt = (fragi >> 2) & 1, gate = (fragi >> 3) & 1, dh = fragi >> 4;
      const int cout = 32 * mt + (ln & 31), cin = 16 * ks + 8 * (ln >> 5) + j;
      const float* W = gate ? p.lru_w_x : p.lru_w_a;
      WF[i] = (h16)W[((size_t)dh * 64 + cin) * 64 + cout];
    }
    for (int i = bid * NT + tid; i < 1024; i += nb * NT) SP[i] = -8.0f * 1.4426950408889634f * log1pf(expf(-p.lru_lambda[i]));
  }
  {
    const int wid = tid >> 6, lane = tid & 63, gw = bid * 8 + wid, nw = nb * 8;
    for (int row = gw; row < 32768; row += nw) {
      const bool isv = row >= 16384; const int rr = row & 16383;
      const f32x4* src = (const f32x4*)((isv ? p.peer_v : p.peer_u) + (size_t)rr * 1024 + lane * 16);
      const f32x4 a = src[0], b = src[1], c = src[2], d = src[3];
      float am = 0.0f;
#pragma unroll
      for (int j = 0; j < 4; ++j) am = fmaxf(fmaxf(am, fabsf(a[j])), fmaxf(fmaxf(fabsf(b[j]), fabsf(c[j])), fabsf(d[j])));
      am = __uint_as_float(wave_max_u(__float_as_uint(am)));
      u32x4 o;
      if (isv) {
        const float sc = am > 0.0f ? 448.0f / am : 1.0f;
        int w;
        w = __builtin_amdgcn_cvt_pk_fp8_f32(a[0] * sc, a[1] * sc, 0, false); w = __builtin_amdgcn_cvt_pk_fp8_f32(a[2] * sc, a[3] * sc, w, true); o[0] = (unsigned)w;
        w = __builtin_amdgcn_cvt_pk_fp8_f32(b[0] * sc, b[1] * sc, 0, false); w = __builtin_amdgcn_cvt_pk_fp8_f32(b[2] * sc, b[3] * sc, w, true); o[1] = (unsigned)w;
        w = __builtin_amdgcn_cvt_pk_fp8_f32(c[0] * sc, c[1] * sc, 0, false); w = __builtin_amdgcn_cvt_pk_fp8_f32(c[2] * sc, c[3] * sc, w, true); o[2] = (unsigned)w;
        w = __builtin_amdgcn_cvt_pk_fp8_f32(d[0] * sc, d[1] * sc, 0, false); w = __builtin_amdgcn_cvt_pk_fp8_f32(d[2] * sc, d[3] * sc, w, true); o[3] = (unsigned)w;
      } else {
        const float sc = am > 0.0f ? 127.0f / am : 1.0f;
        auto q4 = [&](const f32x4& v) -> unsigned {
          const int q0 = (int)rintf(v[0] * sc), q1 = (int)rintf(v[1] * sc), q2 = (int)rintf(v[2] * sc), q3 = (int)rintf(v[3] * sc);
          return (unsigned)(q0 & 255) | ((unsigned)(q1 & 255) << 8) | ((unsigned)(q2 & 255) << 16) | ((unsigned)(q3 & 255) << 24);
        };
        o[0] = q4(a); o[1] = q4(b); o[2] = q4(c); o[3] = q4(d);
      }
      *(u32x4*)(p.ws + (isv ? OFF_VB : OFF_UB) + (size_t)rr * 1024 + lane * 16) = o;
      if (lane == 0) ((float*)(p.ws + (isv ? OFF_VB : OFF_UB) + 16777216))[rr] = am * (isv ? (1.0f / 448.0f) : (1.0f / 127.0f));
    }
  }
}

DEVI void phase0b(const Params& p, char* shm, int bid, int nb) {
  const int tid = threadIdx.x, wid = tid >> 6, lane = tid & 63, gw = bid * 8 + wid, nw = nb * 8;
  const float* MOD = (const float*)(p.ws + OFF_MOD);
  h16* XS = (h16*)(p.ws + OFF_XS);
  float* RSTD1 = (float*)(p.ws + OFF_RSTD1);
  for (int tok = gw; tok < 33792; tok += nw) {
    const int bb = tok < 32768 ? (tok >> 13) : 4;
    const float* src = tok < 32768 ? p.x + (size_t)tok * 1024 : p.ctx + (size_t)(tok - 32768) * 1024;
    const float* mod = MOD + bb * 6144;
    float ss = 0;
#pragma unroll
    for (int i = 0; i < 4; ++i) {
      const int k = i * 256 + lane * 4;
      const f32x4 xv = *(const f32x4*)(src + k), g = *(const f32x4*)(p.norm1_g + k), sc = *(const f32x4*)(mod + 1024 + k);
      ss += (xv[0] * xv[0] + xv[1] * xv[1]) + (xv[2] * xv[2] + xv[3] * xv[3]);
      const f32x4 y = xv * g * (sc + 1.0f);
      h16x4 o = {(h16)y[0], (h16)y[1], (h16)y[2], (h16)y[3]};
      *(h16x4*)(XS + (size_t)tok * 1024 + k) = o;
    }
    ss = wave_sum(ss);
    if (lane == 0) RSTD1[tok] = rsqrtf(ss * (1.0f / 1024.0f) + 1e-6f);
  }
  const h16* WIN = (const h16*)(p.ws + OFF_WIN);
  const h16* WSs = (const h16*)(p.ws + OFF_WS);
  float* BIAS1 = (float*)(p.ws + OFF_BIAS1);
  float* BIAS3 = (float*)(p.ws + OFF_BIAS3);
  for (int n = gw; n < 1536 + 2048; n += nw) {
    const bool is3 = n >= 1536; const int nn = is3 ? n - 1536 : n;
    const h16* wrow = (is3 ? WSs : WIN) + (size_t)nn * 1024;
    const h16x8 w0 = *(const h16x8*)(wrow + lane * 8), w1 = *(const h16x8*)(wrow + 512 + lane * 8);
    const int nv = is3 ? 4 : 5;
    for (int bb = 0; bb < nv; ++bb) {
      const float* sh = MOD + bb * 6144 + (is3 ? 3072 : 0);
      float s = 0;
#pragma unroll
      for (int j = 0; j < 8; ++j) s += (float)w0[j] * sh[lane * 8 + j] + (float)w1[j] * sh[512 + lane * 8 + j];
      s = wave_sum(s);
      if (lane == 0) { if (is3) BIAS3[bb * 2048 + nn] = s; else BIAS1[bb * 1536 + nn] = s; }
    }
  }
}

DEVI void phase1(const Params& p, char* shm, int bid, int nb) {
  const h16* XS = (const h16*)(p.ws + OFF_XS);
  const h16* WIN = (const h16*)(p.ws + OFF_WIN);
  for (int i = 0;; ++i) {
    const long L = (long)i * nb + bid; if (L >= 776) break;
    int pm, pn;
    if (L < 768) tile_order((int)L, 128, 6, pm, pn); else { pm = 128 + (int)(L - 768) / 2; pn = 2 + (int)(L - 768) % 2; }
    if (pn < 2) gemm_tile<1, false>(p, XS, WIN, pm, pn, shm); else gemm_tile<1, true>(p, XS, WIN, pm, pn, shm);
  }
}

typedef float f32x16 __attribute__((ext_vector_type(16)));
template <int CTRL> DEVI float dpp_old(float v, float old) {
  return __builtin_bit_cast(float, __builtin_amdgcn_update_dpp(__builtin_bit_cast(int, old), __builtin_bit_cast(int, v), CTRL, 0xf, 0xf, false));
}
template <int PAT> DEVI float swz(float v) { return __builtin_bit_cast(float, __builtin_amdgcn_ds_swizzle(__builtin_bit_cast(int, v), PAT)); }
template <int D> DEVI void scan32(float& a, float& b, int lane) {
#define LSTEP(CTRL) { const float ap = dpp_old<CTRL>(a, 1.0f), bp = dpp_old<CTRL>(b, 0.0f); b = a * bp + b; a = a * ap; }
  if (D == 0) {
    LSTEP(0x111) LSTEP(0x112) LSTEP(0x114) LSTEP(0x118)
    const float ap = __builtin_bit_cast(float, __builtin_amdgcn_update_dpp(__builtin_bit_cast(int, 1.0f), __builtin_bit_cast(int, a), 0x142, 0xa, 0xf, false));
    const float bp = __builtin_bit_cast(float, __builtin_amdgcn_update_dpp(__builtin_bit_cast(int, 0.0f), __builtin_bit_cast(int, b), 0x142, 0xa, 0xf, false));
    b = a * bp + b; a = a * ap;
  } else {
    LSTEP(0x101) LSTEP(0x102) LSTEP(0x104) LSTEP(0x108)
    float ap = swz<0x200>(a), bp = swz<0x200>(b);
    if (lane & 16) { ap = 1.0f; bp = 0.0f; }
    b = a * bp + b; a = a * ap;
  }
#undef LSTEP
}
constexpr int LRU_WAVE_LDS = 18432, LRU_SSQ_OFF = 8 * LRU_WAVE_LDS;
template <int MODE>
DEVI void lru_unit(const Params& p, char* shm, int q) {
  int tid_o = threadIdx.x; asm volatile("" : "+v"(tid_o));
  const int tid = tid_o, wid = __builtin_amdgcn_readfirstlane(tid >> 6), lane = tid & 63, ch = wid * 64 + lane, half = lane >> 5, ln = lane & 31;
  const h16* UX = (const h16*)(p.ws + OFF_UX);
  h16* xh = (h16*)(shm + wid * LRU_WAVE_LDS);
  h16* hx = xh + 4608;
  float* ssq_l = (float*)(shm + LRU_SSQ_OFF);
  int tok0, lo, hi, b, jj;
  if (q < 512) { tok0 = q * 64; lo = tok0; hi = tok0 + 64; b = q >> 7; jj = 4 + (q & 127); }
  else { const int cq = q - 512; b = cq >> 2; lo = 32768 + b * 256; hi = lo + 256; tok0 = lo + (cq & 3) * 64; jj = cq & 3; }
  {
    const float cw0 = p.conv_w[ch], cw1 = p.conv_w[512 + ch], cw2 = p.conv_w[1024 + ch], cw3 = p.conv_w[1536 + ch], cb = p.conv_b[ch];
    float xv[67];
#pragma unroll
    for (int i = 0; i < 67; ++i) {
      const int tk = tok0 - 2 + i, tkc = tk < lo ? lo : (tk >= hi ? hi - 1 : tk);
      xv[i] = (float)UX[(size_t)tkc * 512 + ch];
    }
    __builtin_amdgcn_sched_barrier(0);
#pragma unroll
    for (int i = 0; i < 67; ++i) {
      const int tk = tok0 - 2 + i;
      const float msk = (tk >= lo && tk < hi) ? 1.0f : 0.0f;
      xv[i] *= msk;
    }
#pragma unroll
    for (int t = 0; t < 64; ++t) xh[t * 72 + lane] = (h16)(cb + cw0 * xv[t] + cw1 * xv[t + 1] + cw2 * xv[t + 2] + cw3 * xv[t + 3]);
  }
  h16x8 Bf[2][4];
#pragma unroll
  for (int nt = 0; nt < 2; ++nt)
#pragma unroll
    for (int ks = 0; ks < 4; ++ks) Bf[nt][ks] = *(const h16x8*)(xh + (32 * nt + ln) * 72 + 16 * ks + 8 * half);
  const h16x8* WF = (const h16x8*)(p.ws + OFF_WF);
  const float* SP = (const float*)(p.ws + OFF_SP);
  const h16* GXG = (const h16*)(p.ws + OFF_GXG);
  const float* CARRY = (const float*)(p.ws + OFF_CARRY);
  f32x2* AGG = (f32x2*)(p.ws + OFF_AGG);
  float ssq[2] = {0.0f, 0.0f};
  h16x8 WA[4], WX[4];
  {
    const h16x8* wfa = WF + ((size_t)(((1 * 8 + wid) * 2 + 0) * 8) * 64 + lane);
    const h16x8* wfx = WF + ((size_t)(((1 * 8 + wid) * 2 + 1) * 8) * 64 + lane);
#pragma unroll
    for (int ks = 0; ks < 4; ++ks) { WA[ks] = wfa[ks * 64]; WX[ks] = wfx[ks * 64]; }
  }
#pragma unroll 1
  for (int mt = 0; mt < 2; ++mt) {
#pragma unroll
    for (int dd = 0; dd < 2; ++dd) {
      const int d = 1 - dd;
      int lane_o = threadIdx.x & 63; asm volatile("" : "+v"(lane_o));
      const int lane = lane_o, half = lane >> 5, ln = lane & 31;
      f32x16 aa[2], ax[2];
#pragma unroll
      for (int nt = 0; nt < 2; ++nt)
#pragma unroll
        for (int r = 0; r < 16; ++r) { aa[nt][r] = 0.0f; ax[nt][r] = 0.0f; }
#pragma unroll
      for (int ks = 0; ks < 4; ++ks) {
#pragma unroll
        for (int nt = 0; nt < 2; ++nt) {
          aa[nt] = __builtin_amdgcn_mfma_f32_32x32x16_f16(WA[ks], Bf[nt][ks], aa[nt], 0, 0, 0);
          ax[nt] = __builtin_amdgcn_mfma_f32_32x32x16_f16(WX[ks], Bf[nt][ks], ax[nt], 0, 0, 0);
        }
      }
      {
        const int dn = dd == 0 ? 0 : 1, mtn = dd == 0 ? mt : (mt < 1 ? mt + 1 : 1);
        const h16x8* wfa = WF + ((size_t)(((dn * 8 + wid) * 2 + 0) * 8 + mtn * 4) * 64 + lane);
        const h16x8* wfx = WF + ((size_t)(((dn * 8 + wid) * 2 + 1) * 8 + mtn * 4) * 64 + lane);
#pragma unroll
        for (int ks = 0; ks < 4; ++ks) { WA[ks] = wfa[ks * 64]; WX[ks] = wfx[ks * 64]; }
      }
#pragma unroll
      for (int g = 0; g < 4; ++g) {
        const int c0 = 32 * mt + 8 * g + 4 * half;
        const f32x4 ba4 = *(const f32x4*)(p.lru_b_a + d * 512 + wid * 64 + c0), bx4 = *(const f32x4*)(p.lru_b_x + d * 512 + wid * 64 + c0);
        const f32x4 sp4 = *(const f32x4*)(SP + d * 512 + wid * 64 + c0);
#pragma unroll
        for (int nt = 0; nt < 2; ++nt) {
          const h16x4 xc4 = *(const h16x4*)(xh + (32 * nt + ln) * 72 + c0);
#pragma unroll
          for (int j = 0; j < 4; ++j) {
            const int r = 4 * g + j;
            const float rg = __builtin_amdgcn_rcpf(1.0f + __builtin_amdgcn_exp2f((aa[nt][r] + ba4[j]) * -1.4426950408889634f));
            const float ig = __builtin_amdgcn_rcpf(1.0f + __builtin_amdgcn_exp2f((ax[nt][r] + bx4[j]) * -1.4426950408889634f));
            const float a = __builtin_amdgcn_exp2f(rg * sp4[j]);
            const float em = __builtin_fmaf(-a, a, 1.0f);
            aa[nt][r] = a; ax[nt][r] = __builtin_amdgcn_sqrtf(em) * ig * (float)xc4[j];
          }
        }
      }
#pragma unroll
      for (int nt = 0; nt < 2; ++nt)
#pragma unroll
        for (int r = 0; r < 16; ++r) { float a = aa[nt][r], bv = ax[nt][r]; if (d) scan32<1>(a, bv, lane); else scan32<0>(a, bv, lane); aa[nt][r] = a; ax[nt][r] = bv; }
#pragma unroll
      for (int r = 0; r < 16; ++r) {
        if (d == 0) { const float ta = swz<0x3E0>(aa[0][r]), tb = swz<0x3E0>(ax[0][r]); ax[1][r] = aa[1][r] * tb + ax[1][r]; aa[1][r] = aa[1][r] * ta; }
        else        { const float ta = swz<0x000>(aa[1][r]), tb = swz<0x000>(ax[1][r]); ax[0][r] = aa[0][r] * tb + ax[0][r]; aa[0][r] = aa[0][r] * ta; }
      }
      if (MODE == 0) {
        if (ln == (d ? 0 : 31)) {
#pragma unroll
          for (int r = 0; r < 16; ++r) {
            const int c = 32 * mt + (r & 3) + 8 * (r >> 2) + 4 * half;
            AGG[((size_t)(b * 132 + jj) * 2 + d) * 512 + wid * 64 + c] = d ? (f32x2){aa[0][r], ax[0][r]} : (f32x2){aa[1][r], ax[1][r]};
          }
        }
      } else {
#pragma unroll
        for (int g = 0; g < 4; ++g) {
          const int c0 = 32 * mt + 8 * g + 4 * half;
          const f32x4 h0 = *(const f32x4*)(CARRY + ((size_t)(b * 128 + (q & 127)) * 2 + d) * 512 + wid * 64 + c0);
#pragma unroll
          for (int nt = 0; nt < 2; ++nt) {
            h16* hp = hx + (32 * nt + ln) * 72 + c0;
            f32x4 hv;
#pragma unroll
            for (int j = 0; j < 4; ++j) hv[j] = aa[nt][4 * g + j] * h0[j] + ax[nt][4 * g + j];
            if (d == 1) {
              *(h16x4*)hp = (h16x4){(h16)hv[0], (h16)hv[1], (h16)hv[2], (h16)hv[3]};
            } else {
              const h16x4 hb4 = *(const h16x4*)hp;
              const h16x4 gxh = *(const h16x4*)(GXG + (size_t)(tok0 + 32 * nt + ln) * 512 + wid * 64 + c0);
              const f32x4 gx4 = {(float)gxh[0], (float)gxh[1], (float)gxh[2], (float)gxh[3]};
              h16x4 o;
#pragma unroll
              for (int j = 0; j < 4; ++j) { const float rx = (hv[j] + (float)hb4[j]) * gx4[j]; ssq[nt] += rx * rx; o[j] = (h16)rx; }
              *(h16x4*)hp = o;
            }
          }
        }
      }
      __builtin_amdgcn_sched_barrier(0);
    }
  }
  if (MODE == 1) {
    int lane_o = threadIdx.x & 63; asm volatile("" : "+v"(lane_o));
    const int lane = lane_o, half = lane >> 5, ln = lane & 31;
#pragma unroll
    for (int nt = 0; nt < 2; ++nt) {
      const float s = ssq[nt] + __shfl_xor(ssq[nt], 32);
      if (half == 0) ssq_l[wid * 64 + 32 * nt + ln] = s;
    }
    __syncthreads();
    h16* A2 = (h16*)(p.ws + OFF_A2);
    const int cc = (lane & 7) * 8;
    const f32x4 ga = *(const f32x4*)(p.lru_out_g + wid * 64 + cc), gb = *(const f32x4*)(p.lru_out_g + wid * 64 + cc + 4);
#pragma unroll 2
    for (int i = 0; i < 8; ++i) {
      const int t = (lane >> 3) + 8 * i;
      float tot = 0;
#pragma unroll
      for (int w = 0; w < 8; ++w) tot += ssq_l[w * 64 + t];
      const float rstd = rsqrtf(tot * (1.0f / 512.0f) + 1e-6f);
      const h16x8 rv = *(const h16x8*)(hx + t * 72 + cc);
      h16x8 o;
#pragma unroll
      for (int j = 0; j < 4; ++j) { o[j] = (h16)((float)rv[j] * rstd * ga[j]); o[4 + j] = (h16)((float)rv[4 + j] * rstd * gb[j]); }
      *(h16x8*)(A2 + (size_t)(tok0 + t) * 1024 + 512 + wid * 64 + cc) = o;
    }
  }
}

DEVI void phase1b(const Params& p, char* shm, int bid, int nb) {
  for (int q = bid; q < 528; q += nb) { __syncthreads(); lru_unit<0>(p, shm, q); }
}

DEVI int fpad(int i) { return i + (i >> 7); }
DEVI void phase2(const Params& p, char* shm, int bid, int nb) {
  const int tid = threadIdx.x, wid = tid >> 6, lane = tid & 63;
  {
    const int gw = bid * 8 + wid;
    if (gw < 64) {
      const int b = gw >> 4, d = (gw >> 3) & 1, ch = (gw & 7) * 64 + lane;
      const f32x2* AGG = (const f32x2*)(p.ws + OFF_AGG);
      float* CARRY = (float*)(p.ws + OFF_CARRY);
      float h = 0.0f;
      for (int s0 = 0; s0 < 132; s0 += 33) {
        f32x2 ab[33];
#pragma unroll
        for (int i = 0; i < 33; ++i) {
          const int s = s0 + i;
          const int j = d == 0 ? s : (s < 4 ? 3 - s : 4 + (131 - s));
          ab[i] = AGG[((size_t)(b * 132 + j) * 2 + d) * 512 + ch];
        }
        __builtin_amdgcn_sched_barrier(0);
#pragma unroll
        for (int i = 0; i < 33; ++i) {
          const int s = s0 + i;
          const int j = d == 0 ? s : (s < 4 ? 3 - s : 4 + (131 - s));
          if (j >= 4) CARRY[((size_t)(b * 128 + (j - 4)) * 2 + d) * 512 + ch] = h;
          h = ab[i][0] * h + ab[i][1];
        }
      }
    }
  }
  f32x2* dt = (f32x2*)shm;
  f32x2* tw = (f32x2*)(shm + 68096);
  {
    const f32x2* TW = (const f32x2*)(p.ws + OFF_TW);
    for (int j = tid; j < 4096; j += NT) tw[fpad(j)] = TW[j];
  }
  h16* GT = (h16*)(p.ws + OFF_GT);
  const float nrm = 0.0013810679320049757f;
  auto dpad = [](int i) -> int { return i + 18 * (i >> 9) + ((i >> 5) & 15); };
  auto twid = [&](int j) -> f32x2 {
    const f32x2 w = tw[fpad(j & 4095)];
    return (j & 4096) ? (f32x2){-w[0], -w[1]} : w;
  };
  for (int u = bid; u < 1024; u += nb) {
    const int b = u >> 8, h = (u >> 5) & 7, m = u & 31;
    const int s0 = m, s1 = m == 0 ? 32 : 64 - m;
    h16* g0 = GT + (size_t)(b * 512 + h * 64 + s0) * 8192;
    h16* g1 = GT + (size_t)(b * 512 + h * 64 + s1) * 8192;
    const float sg = m == 0 ? 1.0f : -1.0f;
    __syncthreads();
#pragma unroll 4
    for (int t = 2 * tid; t < 8192; t += 2 * NT) {
      const h16x2 a0 = *(const h16x2*)(g0 + t), a1 = *(const h16x2*)(g1 + t);
      dt[dpad(t)] = (f32x2){(float)a0[0], sg * (float)a1[0]}; dt[dpad(t + 1)] = (f32x2){(float)a0[1], sg * (float)a1[1]};
    }
    __syncthreads();
#pragma unroll 1
    for (int pass = 0; pass < 3; ++pass) {
      const int lgS = pass == 0 ? 9 : (pass == 1 ? 5 : 1);
      const int S = 1 << lgS;
      const int r = tid & (S - 1), base = ((tid >> lgS) << (lgS + 4)) + r;
      f32x2 x[16];
#pragma unroll
      for (int j = 0; j < 16; ++j) x[j] = dt[dpad(base + (j << lgS))];
      const float c1 = 0.9238795325112867f, s1_ = 0.3826834323650898f, c2 = 0.7071067811865476f;
#define CMULC(v, wr_, wi_) { const float tr = v[0] * (wr_) - v[1] * (wi_), ti = v[0] * (wi_) + v[1] * (wr_); v[0] = tr; v[1] = ti; }
#pragma unroll
      for (int j = 0; j < 8; ++j) { const f32x2 a = x[j], bq = x[j + 8]; x[j] = a + bq; x[j + 8] = a - bq; }
      CMULC(x[9], c1, -s1_) CMULC(x[10], c2, -c2) CMULC(x[11], s1_, -c1) { const f32x2 v = x[12]; x[12] = (f32x2){v[1], -v[0]}; }
      CMULC(x[13], -s1_, -c1) CMULC(x[14], -c2, -c2) CMULC(x[15], -c1, -s1_)
#pragma unroll
      for (int g = 0; g < 16; g += 8)
#pragma unroll
        for (int j = 0; j < 4; ++j) { const f32x2 a = x[g + j], bq = x[g + j + 4]; x[g + j] = a + bq; x[g + j + 4] = a - bq; }
#pragma unroll
      for (int g = 0; g < 16; g += 8) { CMULC(x[g + 5], c2, -c2) { const f32x2 v = x[g + 6]; x[g + 6] = (f32x2){v[1], -v[0]}; } CMULC(x[g + 7], -c2, -c2) }
#pragma unroll
      for (int g = 0; g < 16; g += 4)
#pragma unroll
        for (int j = 0; j < 2; ++j) { const f32x2 a = x[g + j], bq = x[g + j + 2]; x[g + j] = a + bq; x[g + j + 2] = a - bq; }
#pragma unroll
      for (int g = 0; g < 16; g += 4) { const f32x2 v = x[g + 3]; x[g + 3] = (f32x2){v[1], -v[0]}; }
#pragma unroll
      for (int g = 0; g < 16; g += 2) { const f32x2 a = x[g], bq = x[g + 1]; x[g] = a + bq; x[g + 1] = a - bq; }
      const int tsh = 13 - (lgS + 4);
#pragma unroll
      for (int q = 0; q < 16; ++q) {
        const int pos = ((q & 1) << 3) | ((q & 2) << 1) | ((q & 4) >> 1) | ((q & 8) >> 3);
        f32x2 v = x[pos];
        if (q) { const f32x2 w = twid((r * q) << tsh); CMULC(v, w[0], w[1]) }
        dt[dpad(base + (q << lgS))] = v;
      }
#undef CMULC
      __syncthreads();
    }
    auto rdW = [&](int k) -> f32x2 {
      const int pp = ((k & 15) << 9) + (((k >> 4) & 15) << 5) + (((k >> 8) & 15) << 1);
      const f32x2 a = dt[dpad(pp)], bq = dt[dpad(pp + 1)];
      return (k & 4096) ? a - bq : a + bq;
    };
#pragma unroll 2
    for (int k = 2 * tid; k < 8192; k += 2 * NT) {
      float y0[2], y1[2];
#pragma unroll
      for (int u2 = 0; u2 < 2; ++u2) {
        const f32x2 w1 = rdW(k + u2), w2 = rdW((8192 - (k + u2)) & 8191);
        if (m == 0) { y0[u2] = 0.5f * (w1[0] + w2[0]); y1[u2] = 0.5f * (w1[1] + w2[1]); }
        else { y0[u2] = w1[0]; y1[u2] = w2[0]; }
      }
      *(h16x2*)(g0 + k) = (h16x2){(h16)(y0[0] * nrm), (h16)(y0[1] * nrm)};
      *(h16x2*)(g1 + k) = (h16x2){(h16)(y1[0] * nrm), (h16)(y1[1] * nrm)};
    }
  }
}

DEVI void phase3a(const Params& p, char* shm, int bid, int nb) {
  const int tid = threadIdx.x, wid = tid >> 6, lane = tid & 63;
  for (int q = bid; q < 512; q += nb) {
    __syncthreads();
    lru_unit<1>(p, shm, q);
    __syncthreads();
    int tid_o = threadIdx.x; asm volatile("" : "+v"(tid_o));
    const int wid = __builtin_amdgcn_readfirstlane(tid_o >> 6), lane = tid_o & 63;
    const int b = q >> 7, t0 = (q & 127) * 64, tok0 = q * 64;
    const h16* GT = (const h16*)(p.ws + OFF_GT);
    float* yl = (float*)shm + wid * 4160;
    float* ssq_l = (float*)shm + 8 * 4160;
    float ss = 0;
#pragma unroll 32
    for (int m = 0; m < 64; ++m) {
      const float y = (float)GT[(size_t)(b * 512 + wid * 64 + m) * 8192 + t0 + lane];
      yl[m * 65 + lane] = y; ss += y * y;
    }
    ssq_l[wid * 64 + lane] = ss;
    __syncthreads();
    h16* A2 = (h16*)(p.ws + OFF_A2);
    const int mc = (lane & 7) * 8;
    float gg[8];
#pragma unroll
    for (int jj = 0; jj < 8; ++jj) gg[jj] = p.fourier_out_g[wid * 64 + mc + jj];
    for (int i = 0; i < 8; ++i) {
      const int t = (lane >> 3) + 8 * i;
      float tot = 0;
#pragma unroll
      for (int w = 0; w < 8; ++w) tot += ssq_l[w * 64 + t];
      const float rstd = rsqrtf(tot * (1.0f / 512.0f) + 1e-6f);
      h16x8 o;
#pragma unroll
      for (int jj = 0; jj < 8; ++jj) o[jj] = (h16)(yl[(mc + jj) * 65 + t] * rstd * gg[jj]);
      *(h16x8*)(A2 + (size_t)(tok0 + t) * 1024 + wid * 64 + mc) = o;
    }
  }
}

DEVI void phase3b(const Params& p, char* shm, int bid, int nb) {
  const h16* A2 = (const h16*)(p.ws + OFF_A2);
  const h16* WOUT = (const h16*)(p.ws + OFF_WOUT);
  for (int i = 0;; ++i) {
    const long L = (long)i * nb + bid; if (L >= 512) break;
    int pm, pn; tile_order((int)L, 128, 4, pm, pn);
    gemm_tile<2, true>(p, A2, WOUT, pm, pn, shm);
  }
}
DEVI void phase3c(const Params& p, char* shm, int bid, int nb) {
  const h16* H2S = (const h16*)(p.ws + OFF_XS);
  const h16* WSs = (const h16*)(p.ws + OFF_WS);
  for (int i = 0;; ++i) {
    const long L = (long)i * nb + bid; if (L >= 1024) break;
    int pm, pn; tile_order((int)L, 128, 8, pm, pn);
    gemm_tile<3, false>(p, H2S, WSs, pm, pn, shm);
  }
}

#define XB_TMO      128
#define XB_XCNT(j)  (256  + 64 * (j))
#define XB_XSUB(j)  (1280 + 64 * (j))
#define XB_XGEN(j)  (2304 + 64 * (j))
#define XB_TOP      3328
#define XB_TOPGEN   3392
#define XCD_BAR_WORDS 3456
#define XB_SPIN_CAP (1u << 18)
DEVI unsigned xb_ld(unsigned* p)              { return __hip_atomic_load(p, __ATOMIC_RELAXED, __HIP_MEMORY_SCOPE_AGENT); }
DEVI unsigned xb_add(unsigned* p, unsigned v) { return __hip_atomic_fetch_add(p, v, __ATOMIC_RELAXED, __HIP_MEMORY_SCOPE_AGENT); }
DEVI unsigned xb_xcc_id() { return (unsigned)__builtin_amdgcn_s_getreg((3 << 11) | 20) & 0xFu; }
#define XB_SPIN(cond, bar) do { unsigned _sp = 0; while (cond) { __builtin_amdgcn_s_sleep(1); \
    if ((++_sp & 255u) == 0u) { if (xb_ld(&(bar)[XB_TMO])) break; if (_sp > XB_SPIN_CAP) { atomicAdd(&(bar)[XB_TMO], 1u); break; } } } } while (0)
struct XcdBarrier { unsigned* bar; unsigned x; volatile LAS unsigned* st; };
DEVI XcdBarrier xcd_barrier_post(unsigned* bar, volatile LAS unsigned* st) {
  XcdBarrier b; b.bar = bar; b.x = xb_xcc_id(); b.st = st;
  if (threadIdx.x == 0) (void)xb_add(&bar[XB_XCNT(b.x)], 1u);
  return b;
}
DEVI void xcd_barrier_complete(unsigned* bar, unsigned x, unsigned& nloc, unsigned& nx) {
  const unsigned G = gridDim.x * gridDim.y * gridDim.z;
  unsigned sum, cnt, mine, sp = 0u;
  for (;;) {
    sum = 0u; cnt = 0u; mine = 0u;
#pragma unroll
    for (unsigned j = 0; j < 16; ++j) { const unsigned c = xb_ld(&bar[XB_XCNT(j)]); sum += c; cnt += (c > 0u) ? 1u : 0u; mine = (j == x) ? c : mine; }
    if (sum == G) break;
    __builtin_amdgcn_s_sleep(1);
    if ((++sp & 255u) == 0u) { if (xb_ld(&bar[XB_TMO])) break; if (sp > XB_SPIN_CAP) { atomicAdd(&bar[XB_TMO], 1u); break; } }
  }
  nloc = mine > 0u ? mine : 1u; nx = cnt > 0u ? cnt : 1u;
}
DEVI void xcd_barrier(const XcdBarrier& b) {
  asm volatile("s_waitcnt vmcnt(0)" ::: "memory");
  __syncthreads();
  if (threadIdx.x == 0) {
    unsigned* bar = b.bar;
    __builtin_amdgcn_s_waitcnt(0);
    unsigned nloc = b.st[0], nx = b.st[1];
    if (nloc == 0u) { xcd_barrier_complete(bar, b.x, nloc, nx); b.st[0] = nloc; b.st[1] = nx; }
    const unsigned old = xb_add(&bar[XB_XSUB(b.x)], 1u);
    const unsigned gen = old / nloc;
    if (old + 1u == (gen + 1u) * nloc) {
      __builtin_amdgcn_fence(__ATOMIC_RELEASE, "agent");
      asm volatile("s_waitcnt vmcnt(0)" ::: "memory");
      const unsigned og = xb_add(&bar[XB_TOP], 1u);
      const unsigned tg = og / nx;
      if (og + 1u == (tg + 1u) * nx) xb_add(&bar[XB_TOPGEN], 1u);
      else XB_SPIN(xb_ld(&bar[XB_TOPGEN]) == tg, bar);
      __builtin_amdgcn_fence(__ATOMIC_ACQUIRE, "agent");
      xb_add(&bar[XB_XGEN(b.x)], 1u);
      asm volatile("s_waitcnt vmcnt(0)" ::: "memory");
    } else {
      XB_SPIN(xb_ld(&bar[XB_XGEN(b.x)]) == gen, bar);
      __builtin_amdgcn_fence(__ATOMIC_ACQUIRE, "agent");
      asm volatile("s_waitcnt vmcnt(0)" ::: "memory");
    }
  }
  __syncthreads();
}

template <int XM> DEVI unsigned swz_xor(unsigned v) { return (unsigned)__builtin_amdgcn_ds_swizzle((int)v, 0x1F | (XM << 10)); }
template <int K, int J> DEVI void bitonic_step(unsigned (&x)[8], int lane) {
  if constexpr (J < 8) {
#pragma unroll
    for (int r = 0; r < 8; ++r) if ((r & J) == 0) {
      const unsigned a = x[r], b = x[r | J], mn = a < b ? a : b, mx = a < b ? b : a;
      if constexpr (K < 8) { const bool asc = (r & K) == 0; x[r] = asc ? mn : mx; x[r | J] = asc ? mx : mn; }
      else { const bool asc = K >= 512 ? true : ((lane & (K >> 3)) == 0); x[r] = asc ? mn : mx; x[r | J] = asc ? mx : mn; }
    }
  } else {
    constexpr int XL = J >> 3;
    const bool asc = K >= 512 ? true : ((lane & (K >> 3)) == 0);
    const bool lower = (lane & XL) == 0;
    const bool take_min = (asc == lower);
#pragma unroll
    for (int r = 0; r < 8; ++r) {
      unsigned o;
      if constexpr (XL < 32) o = swz_xor<XL>(x[r]); else o = (unsigned)__shfl_xor((int)x[r], 32);
      const unsigned mn = x[r] < o ? x[r] : o, mx = x[r] < o ? o : x[r];
      x[r] = take_min ? mn : mx;
    }
  }
}
template <int K, int J> DEVI void bitonic_merge(unsigned (&x)[8], int lane) {
  bitonic_step<K, J>(x, lane);
  if constexpr (J > 1) bitonic_merge<K, J / 2>(x, lane);
}
template <int K> DEVI void bitonic_sort(unsigned (&x)[8], int lane) {
  if constexpr (K > 2) bitonic_sort<K / 2>(x, lane);
  bitonic_merge<K, K / 2>(x, lane);
}

DEVI void phase3d(const Params& p, char* shm, int bid, int nb, float* const outp) {
  const int tid = threadIdx.x, wid = tid >> 6, lane = tid & 63, grp = lane >> 4, q16 = lane & 15;
  const float* MOD = (const float*)(p.ws + OFF_MOD);
  const float* SSQ2 = (const float*)(p.ws + OFF_SSQ2);
  const unsigned* TOPK = (const unsigned*)(p.ws + OFF_UX);
  const unsigned char* UB8 = (const unsigned char*)(p.ws + OFF_UB);
  const unsigned char* VB8 = (const unsigned char*)(p.ws + OFF_VB);
  const float* SU = (const float*)(p.ws + OFF_UB + 16777216);
  const float* SV = (const float*)(p.ws + OFF_VB + 16777216);
  const h16* X1 = (const h16*)(p.ws + OFF_GXG);
  char* wbase = shm + wid * 7168;
  unsigned* kl = (unsigned*)wbase; float* gl = (float*)(wbase + 2048); float* sl = (float*)(wbase + 4096);
  for (int qd = bid * 8 + wid; qd < 8192; qd += nb * 8) {
    const int tokb = qd * 4;
    const int tok = tokb + grp;
    const float* mod = MOD + (tokb >> 13) * 6144;
    {
      const int q = lane & 31, part = lane >> 5, jt = q >> 3, hd = q & 7, tk = tokb + jt;
      const u32x4* tA = (const u32x4*)(TOPK + ((size_t)tk * 16 + hd * 2 + part) * 16);
      const u32x4* tB = (const u32x4*)(TOPK + ((size_t)tk * 16 + hd * 2 + (1 - part)) * 16);
      unsigned A[16], B[16];
#pragma unroll
      for (int i = 0; i < 4; ++i) { const u32x4 a = tA[i], bq = tB[i];
#pragma unroll
        for (int c = 0; c < 4; ++c) { A[4 * i + c] = a[c]; B[4 * i + c] = bq[c]; } }
      unsigned char* ib = (unsigned char*)(wbase + 6144);
      if (part == 0) {
#pragma unroll
        for (int i = 0; i < 4; ++i) {
          ((unsigned*)ib)[q * 8 + i] = (A[4 * i] & 127u) | ((A[4 * i + 1] & 127u) << 8) | ((A[4 * i + 2] & 127u) << 16) | ((A[4 * i + 3] & 127u) << 24);
          ((unsigned*)ib)[q * 8 + 4 + i] = (B[4 * i] & 127u) | ((B[4 * i + 1] & 127u) << 8) | ((B[4 * i + 2] & 127u) << 16) | ((B[4 * i + 3] & 127u) << 24);
        }
      }
      float va[4], vb[16];
#pragma unroll
      for (int k = 0; k < 4; ++k) va[k] = key2f(A[k] & ~127u);
#pragma unroll
      for (int k = 0; k < 16; ++k) vb[k] = key2f(B[k] & ~127u);
      unsigned Ls[16];
#pragma unroll
      for (int k = 0; k < 16; ++k) Ls[k] = 0u;
#pragma unroll
      for (int a = 0; a < 4; ++a)
#pragma unroll
        for (int bb = a; bb < 16; ++bb) if ((a + 1) * (bb + 1) <= 16) {
          unsigned x = (f2key(va[a] + vb[bb]) & ~511u) | (unsigned)(part << 8) | (unsigned)(a << 4) | (unsigned)bb;
          if (a == bb) x = part ? 0u : x;
#pragma unroll
          for (int k = 0; k < 16; ++k) { const unsigned hi = umax(Ls[k], x); x = Ls[k] < x ? Ls[k] : x; Ls[k] = hi; }
        }
      unsigned C[16];
#pragma unroll
      for (int k = 0; k < 16; ++k) C[k] = umax(Ls[k], (unsigned)__shfl_xor((int)Ls[15 - k], 32));
#pragma unroll
      for (int d = 8; d >= 1; d >>= 1)
#pragma unroll
        for (int k = 0; k < 16; ++k) if ((k & d) == 0) { const unsigned a = C[k], c2 = C[k + d]; C[k] = umax(a, c2); C[k + d] = a < c2 ? a : c2; }
      float ex[16]; float den = 0.0f;
      const float smax = key2f(C[0] & ~511u);
#pragma unroll
      for (int k = 0; k < 16; ++k) { ex[k] = __expf(key2f(C[k] & ~511u) - smax); den += ex[k]; }
      const float rden = 1.0f / den;
      if (part == 0) {
#pragma unroll
        for (int k = 0; k < 16; ++k) {
          const unsigned c = C[k], pp = (c >> 8) & 1u, a = (c >> 4) & 15u, bb = c & 15u;
          const unsigned i1 = pp ? bb : a, i2 = pp ? a : bb;
          const unsigned ex_id = ((unsigned)ib[q * 32 + i1] * 128u + (unsigned)ib[q * 32 + 16 + i2]);
          const int slot = jt * 128 + hd * 16 + k;
          kl[slot] = (ex_id << 9) | (unsigned)slot;
          gl[slot] = ex[k] * rden * SV[ex_id];
          sl[slot] = SU[ex_id];
        }
      }
    }
    unsigned ks[8];
    {
      const u32x4 k0 = *(const u32x4*)(kl + grp * 128 + q16 * 8), k1 = *(const u32x4*)(kl + grp * 128 + q16 * 8 + 4);
#pragma unroll
      for (int c = 0; c < 4; ++c) { ks[c] = k0[c]; ks[4 + c] = k1[c]; }
    }
    bitonic_sort<128>(ks, q16);
    int hq[16]; float sx;
    {
      const f32x4 sq = *(const f32x4*)(SSQ2 + (size_t)tok * 4);
      const float rstd2 = rsqrtf(((sq[0] + sq[1]) + (sq[2] + sq[3])) * (1.0f / 1024.0f) + 1e-6f);
      f32x4 hv[16]; float am = 0.0f;
#pragma unroll
      for (int i = 0; i < 4; ++i) {
        __builtin_amdgcn_sched_barrier(0);
#pragma unroll
        for (int c = 0; c < 4; ++c) {
          const int el = 256 * i + 16 * q16 + 4 * c;
          const h16x4 xh_ = *(const h16x4*)(X1 + (size_t)tok * 1024 + el); const f32x4 xv = {(float)xh_[0], (float)xh_[1], (float)xh_[2], (float)xh_[3]};
          const f32x4 g = *(const f32x4*)(p.norm2_g + el), sc = *(const f32x4*)(mod + 4096 + el), sh = *(const f32x4*)(mod + 3072 + el);
          const f32x4 h = xv * rstd2 * g * (sc + 1.0f) + sh;
          hv[i * 4 + c] = h;
          am = fmaxf(fmaxf(am, fmaxf(fabsf(h[0]), fabsf(h[1]))), fmaxf(fabsf(h[2]), fabsf(h[3])));
        }
      }
      __builtin_amdgcn_sched_barrier(0);
      { unsigned m = __float_as_uint(am); m = umax(m, dpp_u<0xB1>(m)); m = umax(m, dpp_u<0x4E>(m)); m = umax(m, dpp_u<0x141>(m)); m = umax(m, dpp_u<0x140>(m)); am = __uint_as_float(m); }
      const float qs = am > 0.0f ? 127.0f / am : 1.0f;
      sx = am * (1.0f / 127.0f);
#pragma unroll
      for (int k = 0; k < 16; ++k) {
        const int q0 = (int)rintf(hv[k][0] * qs), q1 = (int)rintf(hv[k][1] * qs), q2 = (int)rintf(hv[k][2] * qs), q3 = (int)rintf(hv[k][3] * qs);
        hq[k] = (int)((unsigned)(q0 & 255) | ((unsigned)(q1 & 255) << 8) | ((unsigned)(q2 & 255) << 16) | ((unsigned)(q3 & 255) << 24));
      }
    }
#define KEY_AT(RR, LL) ((unsigned)__shfl((int)ks[RR], (lane & 48) | (LL)))
#define U_LOAD(S, KEYV) { const unsigned key_ = (KEYV); \
      const unsigned char* ub_ = UB8 + (size_t)(key_ >> 9) * 1024 + q16 * 16; \
      _Pragma("unroll") for (int i = 0; i < 4; ++i) UR[S][i] = *(const u32x4*)(ub_ + 256 * i); \
      SUv[S] = sl[key_ & 511u]; GGv[S] = gl[key_ & 511u]; SLv[S] = key_ & 511u; }
#define U_COMPUTE(S) { \
      int a0_ = 0, a1_ = 0, a2_ = 0, a3_ = 0; \
      _Pragma("unroll") for (int i = 0; i < 4; ++i) { \
        a0_ = __builtin_amdgcn_sdot4((int)UR[S][i][0], hq[i * 4 + 0], a0_, false); a1_ = __builtin_amdgcn_sdot4((int)UR[S][i][1], hq[i * 4 + 1], a1_, false); \
        a2_ = __builtin_amdgcn_sdot4((int)UR[S][i][2], hq[i * 4 + 2], a2_, false); a3_ = __builtin_amdgcn_sdot4((int)UR[S][i][3], hq[i * 4 + 3], a3_, false); } \
      const float d = row_sum16((float)((a0_ + a1_) + (a2_ + a3_))) * (SUv[S] * sx); \
      const float w_ = GGv[S] * gelu_tanh_fast(d); \
      if (q16 == 0) gl[SLv[S]] = w_; }
    {
      u32x4 UR[4][4]; float SUv[4], GGv[4]; unsigned SLv[4];
      U_LOAD(0, KEY_AT(0, 0)) U_LOAD(1, KEY_AT(1, 0)) U_LOAD(2, KEY_AT(2, 0))
      unsigned keyn = KEY_AT(3, 0);
#pragma unroll 1
      for (int L = 0; L < 16; ++L) {
        const int Ln = L < 15 ? L + 1 : 15;
#pragma unroll
        for (int r = 0; r < 8; ++r) {
          __builtin_amdgcn_sched_barrier(0);
          U_LOAD((r + 3) & 3, keyn)
          keyn = (r + 4 < 8) ? KEY_AT((r + 4) & 7, L) : KEY_AT((r + 4) & 7, Ln);
          __builtin_amdgcn_sched_barrier(0);
          U_COMPUTE(r & 3)
        }
      }
    }
#undef U_LOAD
#undef U_COMPUTE
    f32x2 acc[32];
#pragma unroll
    for (int i = 0; i < 32; ++i) acc[i] = (f32x2){0.0f, 0.0f};
#define V_LOAD(S, KEYV) { const unsigned key_ = (KEYV); \
      const unsigned char* vb_ = VB8 + (size_t)(key_ >> 9) * 1024 + q16 * 16; \
      _Pragma("unroll") for (int i = 0; i < 4; ++i) VR[S][i] = *(const u32x4*)(vb_ + 256 * i); \
      WWv[S] = gl[key_ & 511u]; }
#define V_COMPUTE(S) { const f32x2 w2 = {WWv[S], WWv[S]}; \
      _Pragma("unroll") for (int i = 0; i < 4; ++i) { \
        _Pragma("unroll") for (int c = 0; c < 4; ++c) { \
          const f32x2 lo = __builtin_amdgcn_cvt_pk_f32_fp8((int)VR[S][i][c], false), hi = __builtin_amdgcn_cvt_pk_f32_fp8((int)VR[S][i][c], true); \
          acc[i * 8 + c * 2] = __builtin_elementwise_fma(w2, lo, acc[i * 8 + c * 2]); acc[i * 8 + c * 2 + 1] = __builtin_elementwise_fma(w2, hi, acc[i * 8 + c * 2 + 1]); } } }
    {
      u32x4 VR[4][4]; float WWv[4];
      V_LOAD(0, KEY_AT(0, 0)) V_LOAD(1, KEY_AT(1, 0)) V_LOAD(2, KEY_AT(2, 0))
      unsigned keyn = KEY_AT(3, 0);
#pragma unroll 1
      for (int L = 0; L < 16; ++L) {
        const int Ln = L < 15 ? L + 1 : 15;
#pragma unroll
        for (int r = 0; r < 8; ++r) {
          __builtin_amdgcn_sched_barrier(0);
          V_LOAD((r + 3) & 3, keyn)
          keyn = (r + 4 < 8) ? KEY_AT((r + 4) & 7, L) : KEY_AT((r + 4) & 7, Ln);
          __builtin_amdgcn_sched_barrier(0);
          V_COMPUTE(r & 3)
        }
      }
    }
#undef V_LOAD
#undef V_COMPUTE
#undef KEY_AT
    {
      f32x4 x2[16]; float ss = 0.0f;
#pragma unroll
      for (int i = 0; i < 4; ++i) {
        __builtin_amdgcn_sched_barrier(0);
#pragma unroll
        for (int c = 0; c < 4; ++c) {
          const int el = 256 * i + 16 * q16 + 4 * c;
          const h16x4 xh_ = *(const h16x4*)(X1 + (size_t)tok * 1024 + el); const f32x4 xv = {(float)xh_[0], (float)xh_[1], (float)xh_[2], (float)xh_[3]};
          const f32x4 g2 = *(const f32x4*)(mod + 5120 + el);
          const f32x4 pr = {acc[i * 8 + c * 2][0], acc[i * 8 + c * 2][1], acc[i * 8 + c * 2 + 1][0], acc[i * 8 + c * 2 + 1][1]};
          const f32x4 v = xv + g2 * pr;
          x2[i * 4 + c] = v;
          ss += (v[0] * v[0] + v[1] * v[1]) + (v[2] * v[2] + v[3] * v[3]);
        }
      }
      __builtin_amdgcn_sched_barrier(0);
      ss = row_sum16(ss);
      const float rstd = rsqrtf(ss * (1.0f / 1024.0f) + 1e-6f);
#pragma unroll
      for (int i = 0; i < 4; ++i)
#pragma unroll
        for (int c = 0; c < 4; ++c) {
          const int el = 256 * i + 16 * q16 + 4 * c;
          *(f32x4*)(outp + (size_t)tok * 1024 + el) = x2[i * 4 + c] * rstd * *(const f32x4*)(p.final_norm_g + el);
        }
    }
  }
}


__global__ void __launch_bounds__(NT) fwd_megakernel(Params p) {
  extern __shared__ __attribute__((aligned(16))) char shm[];
  cg::grid_group grid = cg::this_grid();
  const int bid = blockIdx.x, nb = gridDim.x;
  volatile LAS unsigned* xst = (volatile LAS unsigned*)(shm + LDS_USED);
  if (threadIdx.x < 4) xst[threadIdx.x] = 0u;
  __syncthreads();
  const XcdBarrier xb = xcd_barrier_post((unsigned*)(p.ws + OFF_BAR), xst);
#define GSYNC() xcd_barrier(xb)
  grid.sync();
  phase0a(p, shm, bid, nb); GSYNC();
  phase0b(p, shm, bid, nb); GSYNC();
  phase1(p, shm, bid, nb);  GSYNC();
  phase1b(p, shm, bid, nb); GSYNC();
  phase2(p, shm, bid, nb);  GSYNC();
  phase3a(p, shm, bid, nb); GSYNC();
  phase3b(p, shm, bid, nb); GSYNC();
  phase3c(p, shm, bid, nb); GSYNC();
  phase3d(p, shm, bid, nb, p.out);
}

extern "C" void kernel_launch(void* const* d_in, const int* in_sizes, int n_in, void* d_out, int out_size, void* d_ws, size_t ws_size, hipStream_t stream) {
  if (ws_size < WS_NEED) { fprintf(stderr, "workspace too small: %zu < %zu\n", ws_size, (size_t)WS_NEED); return; }
  Params p{};
  const float** pp = (const float**)&p;
  for (int i = 0; i < 24; ++i) pp[i] = (const float*)d_in[i];
  p.out = (float*)d_out; p.ws = (char*)d_ws;
  static int grid_blocks = 0;
  if (!grid_blocks) {
    hipFuncSetAttribute((const void*)fwd_megakernel, hipFuncAttributeMaxDynamicSharedMemorySize, LDS_BYTES);
    int dev = 0, cus = 0, per_cu = 0;
    hipGetDevice(&dev);
    hipDeviceGetAttribute(&cus, hipDeviceAttributeMultiprocessorCount, dev);
    hipOccupancyMaxActiveBlocksPerMultiprocessor(&per_cu, fwd_megakernel, NT, LDS_BYTES);
    if (per_cu > 1) per_cu = 1;
    grid_blocks = cus * per_cu;
  }
  (void)hipMemsetAsync((char*)d_ws + OFF_BAR, 0, 16384, stream);
  void* args[] = {&p};
  hipError_t e = hipLaunchCooperativeKernel((void*)fwd_megakernel, dim3(grid_blocks), dim3(NT), args, LDS_BYTES, stream);
  if (e != hipSuccess) fprintf(stderr, "cooperative launch failed: %s (grid %d)\n", hipGetErrorString(e), grid_blocks);
}
```

```cpp
#include <hip/hip_runtime.h>
#include <hip/hip_cooperative_groups.h>
#include <cstdio>
#include <cstdint>
namespace cg = cooperative_groups;

typedef _Float16 h16;
typedef _Float16 h16x2 __attribute__((ext_vector_type(2)));
typedef _Float16 h16x4 __attribute__((ext_vector_type(4)));
typedef _Float16 h16x8 __attribute__((ext_vector_type(8)));
typedef float f32x4 __attribute__((ext_vector_type(4)));
typedef float f32x2 __attribute__((ext_vector_type(2)));
typedef unsigned u32x4 __attribute__((ext_vector_type(4)));

#define DEVI __device__ __forceinline__
constexpr int NT = 512;
constexpr int LDS_USED = 151552;
constexpr int LDS_BYTES = LDS_USED + 16;

struct Params {
  const float *x, *c, *ctx, *c_ctx, *w_mod, *b_mod, *norm1_g, *w_in, *conv_w, *conv_b,
      *lru_w_a, *lru_b_a, *lru_w_x, *lru_b_x, *lru_lambda, *fourier_out_g, *lru_out_g,
      *w_out, *norm2_g, *peer_w_q, *peer_sub_keys, *peer_u, *peer_v, *final_norm_g;
  float* out;
  char* ws;
};

constexpr size_t OFF_MOD   = 0;
constexpr size_t OFF_TW    = OFF_MOD   + 122880;
constexpr size_t OFF_BIAS1 = OFF_TW    + 32768;
constexpr size_t OFF_BIAS3 = OFF_BIAS1 + 30720;
constexpr size_t OFF_RSTD1 = OFF_BIAS3 + 32768;
constexpr size_t OFF_SSQ2  = OFF_RSTD1 + 135168;
constexpr size_t OFF_AGG   = OFF_SSQ2  + 524288;
constexpr size_t OFF_CARRY = OFF_AGG   + 4325376;
constexpr size_t OFF_SP    = OFF_CARRY + 2097152;
constexpr size_t OFF_WF    = OFF_SP    + 12288;
constexpr size_t OFF_WIN   = OFF_WF    + 262144;
constexpr size_t OFF_WOUT  = OFF_WIN   + 3145728;
constexpr size_t OFF_WS    = OFF_WOUT  + 2097152;
constexpr size_t OFF_UB    = OFF_WS    + 4194304;
constexpr size_t OFF_VB    = OFF_UB    + 33554432;
constexpr size_t OFF_XS    = OFF_VB    + 33554432;
constexpr size_t OFF_GT    = OFF_XS    + 69206016;
constexpr size_t OFF_UX    = OFF_GT    + 67108864;
constexpr size_t OFF_GXG   = OFF_UX    + 69206016;
constexpr size_t OFF_HB    = OFF_GXG   + 67108864;
constexpr size_t OFF_A2    = OFF_HB    + 67108864;
constexpr size_t OFF_BAR   = OFF_A2    + 67108864;
constexpr size_t WS_NEED   = OFF_BAR   + 16384;

template <int CTRL> DEVI float dpp_f(float v) {
  return __builtin_bit_cast(float, __builtin_amdgcn_update_dpp(0, __builtin_bit_cast(int, v), CTRL, 0xf, 0xf, false));
}
template <int CTRL> DEVI unsigned dpp_u(unsigned v) {
  return (unsigned)__builtin_amdgcn_update_dpp(0, (int)v, CTRL, 0xf, 0xf, false);
}
DEVI float row_sum16(float v) {
  v += dpp_f<0xB1>(v); v += dpp_f<0x4E>(v); v += dpp_f<0x141>(v); v += dpp_f<0x140>(v); return v;
}
DEVI float rl_f(float v, int l) { return __builtin_bit_cast(float, __builtin_amdgcn_readlane(__builtin_bit_cast(int, v), l)); }
DEVI float wave_sum(float v) {
  v = row_sum16(v);
  return (rl_f(v, 0) + rl_f(v, 16)) + (rl_f(v, 32) + rl_f(v, 48));
}
DEVI unsigned umax(unsigned a, unsigned b) { return a > b ? a : b; }
DEVI unsigned wave_max_u(unsigned v) {
  v = umax(v, dpp_u<0xB1>(v)); v = umax(v, dpp_u<0x4E>(v)); v = umax(v, dpp_u<0x141>(v)); v = umax(v, dpp_u<0x140>(v));
  unsigned a = (unsigned)__builtin_amdgcn_readlane((int)v, 0), b = (unsigned)__builtin_amdgcn_readlane((int)v, 16);
  unsigned c = (unsigned)__builtin_amdgcn_readlane((int)v, 32), d = (unsigned)__builtin_amdgcn_readlane((int)v, 48);
  return umax(umax(a, b), umax(c, d));
}
DEVI float gelu_tanh_fast(float x) {
  const float u = 0.7978845608028654f * (x + 0.044715f * x * x * x);
  const float e = __builtin_amdgcn_exp2f(u * 2.8853900817779268f);
  const float t = 1.0f - 2.0f * __builtin_amdgcn_rcpf(1.0f + e);
  return 0.5f * x * (1.0f + t);
}
DEVI float gelu_tanh(float x) {
  float u = 0.7978845608028654f * (x + 0.044715f * x * x * x);
  float e = __expf(2.0f * u);
  float t = 1.0f - 2.0f / (1.0f + e);
  return 0.5f * x * (1.0f + t);
}
DEVI float sigmoidf_(float x) { return 1.0f / (1.0f + __expf(-x)); }
DEVI unsigned f2key(float f) { unsigned u = __float_as_uint(f); return (u & 0x80000000u) ? ~u : (u | 0x80000000u); }
DEVI float key2f(unsigned k) { unsigned u = (k & 0x80000000u) ? (k & 0x7fffffffu) : ~k; return __uint_as_float(u); }

constexpr int BM = 256, BK = 64, HALF = 128, HT = HALF * BK, KD = 1024;
DEVI int lds_byte(int r, int c) {
  int st = (r >> 4) * 2 + (c >> 5), rr = r & 15, cc = c & 31, ob = rr * 64 + cc * 2;
  return st * 1024 + (ob ^ (((ob >> 9) & 1) << 5));
}
DEVI void stage_rc(int b, int& R, int& C) {
  int st = b / 1024, sb = b % 1024, swz = sb ^ (((sb >> 9) & 1) << 5);
  R = (st >> 1) * 16 + swz / 64; C = (st & 1) * 32 + (swz % 64) / 2;
}
DEVI void tile_order(int L, int nM, int nN, int& pm, int& pn) {
  int nwg = nM * nN, wgid = L;
  { int q = nwg / 8, r = nwg % 8, xcd = wgid % 8, off = wgid / 8; wgid = (xcd < r ? xcd * (q + 1) : r * (q + 1) + (xcd - r) * q) + off; }
  int nig = 8 * nN, gid = wgid / nig, fm = gid * 8, gsz = (nM - fm) < 8 ? (nM - fm) : 8;
  pm = fm + ((wgid % nig) % gsz); pn = (wgid % nig) / gsz;
}

#define LAS __attribute__((address_space(3)))
constexpr int HTB = HALF * BK * 2;
template <int EPI, bool TRANS>
DEVI void gemm_tile(const Params& p, const h16* __restrict__ A, const h16* __restrict__ Bt, int pm, int pn, char* shmc) {
  LAS unsigned char* lds = (LAS unsigned char*)shmc;
  int tid_k = threadIdx.x; asm volatile("" : "+v"(tid_k));
  const int tid = tid_k;
  const int brow = pm * BM, bcol = pn * BM;
  const int wid = tid >> 6, lane = tid & 63, wr = wid >> 2, wc = wid & 3, fr = lane & 15, fq = lane >> 4;
  unsigned voff[2];
#pragma unroll
  for (int i = 0; i < 2; ++i) { int R, C; stage_rc(tid * 16 + i * 8192, R, C); voff[i] = (unsigned)(R * KD + C) * 2u; }
  constexpr size_t kstep = (size_t)(BK * 2), hstep = (size_t)HALF * KD * 2;
  const unsigned ldsw = (unsigned)wid * 1024u;
  const int aoff = lds_byte(wr * 64 + fr, fq * 8), boff = lds_byte(wc * 32 + fr, fq * 8);
  const char* cA = (const char*)A + (size_t)brow * KD * 2;
  const char* cB = (const char*)Bt + (size_t)bcol * KD * 2;
#define SA(b, h) (((b) * 2 + (h)) * HTB)
#define SB(b, h) ((4 + (b) * 2 + (h)) * HTB)
#define STAGE(bufoff, gbase) do { _Pragma("unroll") for (int _i = 0; _i < 2; ++_i) \
    __builtin_amdgcn_global_load_lds((const unsigned*)((const char*)(gbase) + voff[_i]), (LAS unsigned*)(lds + (bufoff) + ldsw + _i * 8192), 16, 0, 0); } while (0)
#define LDA(dst, b, h) do { _Pragma("unroll") for (int m = 0; m < 4; ++m) _Pragma("unroll") for (int k = 0; k < 2; ++k) dst[m][k] = *(const LAS h16x8*)(lds + SA(b, h) + aoff + m * 2048 + k * 1024); } while (0)
#define LDB(dst, b, h) do { _Pragma("unroll") for (int n = 0; n < 2; ++n) _Pragma("unroll") for (int k = 0; k < 2; ++k) dst[n][k] = *(const LAS h16x8*)(lds + SB(b, h) + boff + n * 2048 + k * 1024); } while (0)
#define MMA(ai, bj, At_, Bt_) do { __builtin_amdgcn_s_setprio(1); _Pragma("unroll") for (int m = 0; m < 4; ++m) _Pragma("unroll") for (int n = 0; n < 2; ++n) _Pragma("unroll") for (int k = 0; k < 2; ++k) \
      acc[ai][bj][m][n] = TRANS ? __builtin_amdgcn_mfma_f32_16x16x32_f16(Bt_[n][k], At_[m][k], acc[ai][bj][m][n], 0, 0, 0) \
                                : __builtin_amdgcn_mfma_f32_16x16x32_f16(At_[m][k], Bt_[n][k], acc[ai][bj][m][n], 0, 0, 0); \
    __builtin_amdgcn_s_setprio(0); } while (0)
#define WAIT_V(n) asm volatile("s_waitcnt vmcnt(" #n ")" ::: "memory")
#define WAIT_L(n) asm volatile("s_waitcnt lgkmcnt(" #n ")" ::: "memory")
#define BAR __builtin_amdgcn_s_barrier()
#define SCHED __builtin_amdgcn_sched_barrier(0)
  f32x4 acc[2][2][4][2];
#pragma unroll
  for (int a = 0; a < 2; ++a)
#pragma unroll
    for (int b = 0; b < 2; ++b)
#pragma unroll
      for (int m = 0; m < 4; ++m)
#pragma unroll
        for (int n = 0; n < 2; ++n) acc[a][b][m][n] = (f32x4){0.f, 0.f, 0.f, 0.f};
  h16x8 At[4][2], B0[2][2], B1[2][2];
  constexpr int nt = KD / BK;
  STAGE(SB(0, 0), cB); STAGE(SA(0, 0), cA); STAGE(SB(0, 1), cB + hstep); STAGE(SA(0, 1), cA + hstep);
  if (wr == 1) BAR;
  WAIT_V(4); BAR;
  STAGE(SB(1, 0), cB + kstep); STAGE(SA(1, 0), cA + kstep); STAGE(SB(1, 1), cB + hstep + kstep);
  WAIT_V(6); BAR;
#pragma unroll 1
  for (int t = 0; t < nt - 2; t += 2) {
    const char* a1 = cA + (size_t)(t + 1) * kstep;
    const char* a2 = cA + (size_t)(t + 2) * kstep; const char* b2 = cB + (size_t)(t + 2) * kstep;
    const char* a3 = a2 + kstep; const char* b3 = b2 + kstep;
    LDB(B0, 0, 0); SCHED; LDA(At, 0, 0); STAGE(SA(1, 1), a1 + hstep);
    WAIT_L(8); BAR; WAIT_L(0); MMA(0, 0, At, B0); BAR; SCHED;
    LDB(B1, 0, 1); STAGE(SB(0, 0), b2);
    BAR; WAIT_L(0); MMA(0, 1, At, B1); BAR;
    LDA(At, 0, 1); STAGE(SA(0, 0), a2);
    BAR; WAIT_L(0); MMA(1, 0, At, B0); BAR; SCHED;
    STAGE(SB(0, 1), b2 + hstep);
    WAIT_V(6); BAR; MMA(1, 1, At, B1); BAR;
    LDB(B0, 1, 0); SCHED; LDA(At, 1, 0); STAGE(SA(0, 1), a2 + hstep);
    WAIT_L(8); BAR; WAIT_L(0); MMA(0, 0, At, B0); BAR; SCHED;
    LDB(B1, 1, 1); STAGE(SB(1, 0), b3);
    BAR; WAIT_L(0); MMA(0, 1, At, B1); BAR;
    LDA(At, 1, 1); STAGE(SA(1, 0), a3);
    BAR; WAIT_L(0); MMA(1, 0, At, B0); BAR; SCHED;
    STAGE(SB(1, 1), b3 + hstep);
    WAIT_V(6); BAR; MMA(1, 1, At, B1); BAR;
  }
  { LDB(B0, 0, 0); LDA(At, 0, 0); STAGE(SA(1, 1), cA + (size_t)(nt - 1) * kstep + hstep);
    BAR; WAIT_L(0); MMA(0, 0, At, B0); BAR;
    LDB(B1, 0, 1); BAR; WAIT_L(0); MMA(0, 1, At, B1); BAR;
    LDA(At, 0, 1); WAIT_V(4); BAR; WAIT_L(0); MMA(1, 0, At, B0); MMA(1, 1, At, B1); BAR; }
  { LDB(B0, 1, 0); LDA(At, 1, 0); WAIT_V(2); BAR; WAIT_L(0); MMA(0, 0, At, B0); BAR;
    LDB(B1, 1, 1); WAIT_V(0); BAR; WAIT_L(0); MMA(0, 1, At, B1); BAR;
    LDA(At, 1, 1); BAR; WAIT_L(0); MMA(1, 0, At, B0); MMA(1, 1, At, B1); BAR; }
  if (wr == 0) BAR;
#undef SA
#undef SB
#undef STAGE
#undef LDA
#undef LDB
#undef MMA
  int tid_e = threadIdx.x; asm volatile("" : "+v"(tid_e));
  {
  const int tid = tid_e, wid = tid >> 6, lane = tid & 63, wr = wid >> 2, wc = wid & 3, fr = lane & 15, fq = lane >> 4;
  (void)lane; (void)wr; (void)wc; (void)fr; (void)fq;
  if constexpr (EPI == 1) {
    const float* RSTD1 = (const float*)(p.ws + OFF_RSTD1);
    const float* BIAS1 = (const float*)(p.ws + OFF_BIAS1);
    const int bb = brow < 32768 ? (brow >> 13) : 4;
    if constexpr (!TRANS) {
      h16* GT = (h16*)(p.ws + OFF_GT);
#pragma unroll
      for (int ai = 0; ai < 2; ++ai)
#pragma unroll
        for (int m = 0; m < 4; ++m) {
          const int row0 = brow + ai * 128 + wr * 64 + m * 16 + fq * 4;
          const f32x4 rs = *(const f32x4*)(RSTD1 + row0);
#pragma unroll
          for (int bj = 0; bj < 2; ++bj)
#pragma unroll
            for (int n = 0; n < 2; ++n) {
              const int col = bcol + bj * 128 + wc * 32 + n * 16 + fr;
              const float bias = BIAS1[bb * 1536 + col];
              const f32x4 gv = acc[ai][bj][m][n] * rs + bias;
              *(h16x4*)(GT + ((size_t)(bb * 512 + col) * 8192 + (row0 & 8191))) = (h16x4){(h16)gv[0], (h16)gv[1], (h16)gv[2], (h16)gv[3]};
            }
        }
    } else {
      h16* UX = (h16*)(p.ws + OFF_UX);
      h16* GXG = (h16*)(p.ws + OFF_GXG);
#pragma unroll
      for (int ai = 0; ai < 2; ++ai)
#pragma unroll
        for (int m = 0; m < 4; ++m) {
          const int row = brow + ai * 128 + wr * 64 + m * 16 + fr;
          const float rs = RSTD1[row];
#pragma unroll
          for (int bj = 0; bj < 2; ++bj)
#pragma unroll
            for (int n = 0; n < 2; ++n) {
              const int col0 = bcol + bj * 128 + wc * 32 + n * 16 + fq * 4;
              const f32x4 bias = *(const f32x4*)(BIAS1 + bb * 1536 + col0);
              f32x4 v = acc[ai][bj][m][n] * rs + bias;
              if (pn < 4) *(h16x4*)(UX + (size_t)row * 512 + (col0 - 512)) = (h16x4){(h16)v[0], (h16)v[1], (h16)v[2], (h16)v[3]};
              else { v[0] = gelu_tanh_fast(v[0]); v[1] = gelu_tanh_fast(v[1]); v[2] = gelu_tanh_fast(v[2]); v[3] = gelu_tanh_fast(v[3]); *(h16x4*)(GXG + (size_t)row * 512 + (col0 - 1024)) = (h16x4){(h16)v[0], (h16)v[1], (h16)v[2], (h16)v[3]}; }
            }
        }
    }
  } else if constexpr (EPI == 2) {
    static_assert(EPI != 2 || TRANS, "EPI 2 uses transposed accumulators");
    const float* MOD = (const float*)(p.ws + OFF_MOD);
    float* SSQ2 = (float*)(p.ws + OFF_SSQ2);
    h16* X1 = (h16*)(p.ws + OFF_GXG);
    float* red = (float*)shmc;
    const int b = brow >> 13;
    f32x4 g1v[2][2];
#pragma unroll
    for (int bj = 0; bj < 2; ++bj)
#pragma unroll
      for (int n = 0; n < 2; ++n) g1v[bj][n] = *(const f32x4*)(MOD + b * 6144 + 2048 + bcol + bj * 128 + wc * 32 + n * 16 + fq * 4);
#pragma unroll
    for (int am = 0; am < 4; ++am) {
      const int ai = am >> 1, m0 = (am & 1) * 2;
      f32x4 xv[2][2][2];
#pragma unroll
      for (int mm = 0; mm < 2; ++mm)
#pragma unroll
        for (int bj = 0; bj < 2; ++bj)
#pragma unroll
          for (int n = 0; n < 2; ++n)
            xv[mm][bj][n] = *(const f32x4*)(p.x + (size_t)(brow + ai * 128 + wr * 64 + (m0 + mm) * 16 + fr) * 1024 + bcol + bj * 128 + wc * 32 + n * 16 + fq * 4);
      __builtin_amdgcn_sched_barrier(0);
#pragma unroll
      for (int mm = 0; mm < 2; ++mm) {
        const int m = m0 + mm;
        const int row = brow + ai * 128 + wr * 64 + m * 16 + fr;
        float ss = 0.0f;
#pragma unroll
        for (int bj = 0; bj < 2; ++bj)
#pragma unroll
          for (int n = 0; n < 2; ++n) {
            const int col0 = bcol + bj * 128 + wc * 32 + n * 16 + fq * 4;
            const size_t o = (size_t)row * 1024 + col0;
            const f32x4 x1 = xv[mm][bj][n] + g1v[bj][n] * acc[ai][bj][m][n];
            *(h16x4*)(X1 + o) = (h16x4){(h16)x1[0], (h16)x1[1], (h16)x1[2], (h16)x1[3]};
            ss += (x1[0] * x1[0] + x1[1] * x1[1]) + (x1[2] * x1[2] + x1[3] * x1[3]);
          }
        ss += __shfl_xor(ss, 16); ss += __shfl_xor(ss, 32);
        if (fq == 0) red[wc * 256 + ai * 128 + wr * 64 + m * 16 + fr] = ss;
      }
    }
    __syncthreads();
    if (tid < 256) {
      const int r = tid;
      SSQ2[(size_t)(brow + r) * 4 + pn] = (red[r] + red[256 + r]) + (red[512 + r] + red[768 + r]);
    }
  } else if constexpr (EPI == 3) {
    const float* SSQ2 = (const float*)(p.ws + OFF_SSQ2);
    const float* BIAS3 = (const float*)(p.ws + OFF_BIAS3);
    unsigned* TOPK = (unsigned*)(p.ws + OFF_UX);
    float* sc = (float*)shmc;
    float* rstd_l = (float*)(shmc + 139264);
    const int b = brow >> 13;
    if (tid < 256) {
      const f32x4 q = *(const f32x4*)(SSQ2 + (size_t)(brow + tid) * 4);
      rstd_l[tid] = rsqrtf(((q[0] + q[1]) + (q[2] + q[3])) * (1.0f / 1024.0f) + 1e-6f);
    }
#pragma unroll
    for (int bj = 0; bj < 2; ++bj) {
      __syncthreads();
#pragma unroll
      for (int ai = 0; ai < 2; ++ai)
#pragma unroll
        for (int m = 0; m < 4; ++m) {
          const int r0 = ai * 128 + wr * 64 + m * 16 + fq * 4;
          const f32x4 rstd = *(const f32x4*)(rstd_l + r0);
#pragma unroll
          for (int n = 0; n < 2; ++n) {
            const int cl = wc * 32 + n * 16 + fr;
            const float bias = BIAS3[b * 2048 + bcol + bj * 128 + cl];
            const int pc = cl + 4 * (cl >> 6);
#pragma unroll
            for (int j = 0; j < 4; ++j) sc[(r0 + j) * 136 + pc] = acc[ai][bj][m][n][j] * rstd[j] + bias;
          }
        }
      __syncthreads();
      {
        const int row = tid >> 1, hf = tid & 1;
        const float* rp = sc + row * 136 + hf * 68;
        unsigned Lq[4][16];
#pragma unroll
        for (int i4 = 0; i4 < 4; ++i4) {
          f32x4 v[4];
#pragma unroll
          for (int c = 0; c < 4; ++c) v[c] = *(const f32x4*)(rp + (c * 4 + i4) * 4);
#pragma unroll
          for (int j = 0; j < 4; ++j)
#pragma unroll
            for (int c = 0; c < 4; ++c) Lq[c][i4 * 4 + j] = (f2key(v[c][j]) & ~127u) | (unsigned)(hf * 64 + (c * 4 + i4) * 4 + j);
        }
#pragma unroll
        for (int k = 2; k <= 16; k <<= 1)
#pragma unroll
          for (int j = k >> 1; j >= 1; j >>= 1)
#pragma unroll
            for (int i = 0; i < 16; ++i) if ((i & j) == 0) {
              const bool desc = (i & k) == 0;
#pragma unroll
              for (int c = 0; c < 4; ++c) {
                const unsigned a = Lq[c][i], b = Lq[c][i | j], mx = umax(a, b), mn = a < b ? a : b;
                Lq[c][i] = desc ? mx : mn; Lq[c][i | j] = desc ? mn : mx;
              }
            }
        auto merge16 = [](unsigned (&A)[16], const unsigned (&B)[16]) {
#pragma unroll
          for (int k = 0; k < 16; ++k) A[k] = umax(A[k], B[15 - k]);
#pragma unroll
          for (int d = 8; d >= 1; d >>= 1)
#pragma unroll
            for (int k = 0; k < 16; ++k) if ((k & d) == 0) { const unsigned a = A[k], c2 = A[k + d]; A[k] = umax(a, c2); A[k + d] = a < c2 ? a : c2; }
        };
        merge16(Lq[0], Lq[1]); merge16(Lq[2], Lq[3]); merge16(Lq[0], Lq[2]);
        unsigned (&L)[16] = Lq[0];
        unsigned C[16];
#pragma unroll
        for (int k = 0; k < 16; ++k) C[k] = umax(L[k], dpp_u<0xB1>(L[15 - k]));
#pragma unroll
        for (int d = 8; d >= 1; d >>= 1)
#pragma unroll
          for (int k = 0; k < 16; ++k) if ((k & d) == 0) { const unsigned a = C[k], c2 = C[k + d]; C[k] = umax(a, c2); C[k + d] = a < c2 ? a : c2; }
        unsigned* dst = TOPK + ((size_t)(brow + row) * 16 + (pn * 2 + bj)) * 16;
        if (hf == 0) { *(u32x4*)dst = (u32x4){C[0], C[1], C[2], C[3]}; *(u32x4*)(dst + 4) = (u32x4){C[4], C[5], C[6], C[7]}; }
        else { *(u32x4*)(dst + 8) = (u32x4){C[8], C[9], C[10], C[11]}; *(u32x4*)(dst + 12) = (u32x4){C[12], C[13], C[14], C[15]}; }
      }
    }
  }
  }
  __syncthreads();
}

DEVI void phase0a(const Params& p, char* shm, int bid, int nb) {
  const int tid = threadIdx.x;
  float* MOD = (float*)(p.ws + OFF_MOD);
  h16* WIN = (h16*)(p.ws + OFF_WIN);
  h16* WOUT = (h16*)(p.ws + OFF_WOUT);
  h16* WSs = (h16*)(p.ws + OFF_WS);
  const int lane0 = tid & 63, gw0 = bid * 8 + (tid >> 6), nw0 = nb * 8;
  auto tload = [&](int row, f32x4 (&r)[4]) {
    const int rc = row < 32768 ? row : 32767;
    const bool isv = rc >= 16384; const int rr = rc & 16383;
    const f32x4* src = (const f32x4*)((isv ? p.peer_v : p.peer_u) + (size_t)rr * 1024 + lane0 * 16);
    r[0] = src[0]; r[1] = src[1]; r[2] = src[2]; r[3] = src[3];
  };
  auto tconv = [&](int row, const f32x4 (&r)[4]) {
    if (row >= 32768) return;
    const bool isv = row >= 16384; const int rr = row & 16383;
    const f32x4 a = r[0], b = r[1], c = r[2], d = r[3];
    float am = 0.0f;
#pragma unroll
    for (int j = 0; j < 4; ++j) am = fmaxf(fmaxf(am, fabsf(a[j])), fmaxf(fmaxf(fabsf(b[j]), fabsf(c[j])), fabsf(d[j])));
    am = __uint_as_float(wave_max_u(__float_as_uint(am)));
    u32x4 o;
    if (isv) {
      const float sc = am > 0.0f ? 448.0f / am : 1.0f;
      int w;
      w = __builtin_amdgcn_cvt_pk_fp8_f32(a[0] * sc, a[1] * sc, 0, false); w = __builtin_amdgcn_cvt_pk_fp8_f32(a[2] * sc, a[3] * sc, w, true); o[0] = (unsigned)w;
      w = __builtin_amdgcn_cvt_pk_fp8_f32(b[0] * sc, b[1] * sc, 0, false); w = __builtin_amdgcn_cvt_pk_fp8_f32(b[2] * sc, b[3] * sc, w, true); o[1] = (unsigned)w;
      w = __builtin_amdgcn_cvt_pk_fp8_f32(c[0] * sc, c[1] * sc, 0, false); w = __builtin_amdgcn_cvt_pk_fp8_f32(c[2] * sc, c[3] * sc, w, true); o[2] = (unsigned)w;
      w = __builtin_amdgcn_cvt_pk_fp8_f32(d[0] * sc, d[1] * sc, 0, false); w = __builtin_amdgcn_cvt_pk_fp8_f32(d[2] * sc, d[3] * sc, w, true); o[3] = (unsigned)w;
    } else {
      const float sc = am > 0.0f ? 127.0f / am : 1.0f;
      auto q4 = [&](const f32x4& v) -> unsigned {
        const int q0 = (int)rintf(v[0] * sc), q1 = (int)rintf(v[1] * sc), q2 = (int)rintf(v[2] * sc), q3 = (int)rintf(v[3] * sc);
        return (unsigned)(q0 & 255) | ((unsigned)(q1 & 255) << 8) | ((unsigned)(q2 & 255) << 16) | ((unsigned)(q3 & 255) << 24);
      };
      o[0] = q4(a); o[1] = q4(b); o[2] = q4(c); o[3] = q4(d);
    }
    *(u32x4*)(p.ws + (isv ? OFF_VB : OFF_UB) + (size_t)rr * 1024 + lane0 * 16) = o;
    if (lane0 == 0) ((float*)(p.ws + (isv ? OFF_VB : OFF_UB) + 16777216))[rr] = am * (isv ? (1.0f / 448.0f) : (1.0f / 127.0f));
  };
#define TLOAD() { _Pragma("unroll") for (int j = 0; j < 4; ++j) tload(rbase + j * nw0, R[j]); }
  int it = 0;
  for (int u = bid; u < 1089; u += nb, ++it) {
    __syncthreads();
    f32x4 R[4][4];
    const int rbase = gw0 + it * 4 * nw0;
    if (u < 192) {
      float* s = (float*)shm; float* red = s + 5120;
      for (int i = tid; i < 5120; i += NT) { const int v = i >> 10, k = i & 1023; const float xv = v < 4 ? p.c[v * 1024 + k] : p.c_ctx[k]; s[i] = xv / (1.0f + expf(-xv)); }
      TLOAD();
      __syncthreads();
      const int cl = tid & 31, kg = tid >> 5, n = u * 32 + cl;
      float a0 = 0, a1 = 0, a2 = 0, a3 = 0, a4 = 0;
      for (int k = kg; k < 1024; k += 16) { const float w = p.w_mod[(size_t)k * 6144 + n]; a0 += s[k] * w; a1 += s[1024 + k] * w; a2 += s[2048 + k] * w; a3 += s[3072 + k] * w; a4 += s[4096 + k] * w; }
      float* rr = red + (kg * 32 + cl) * 5; rr[0] = a0; rr[1] = a1; rr[2] = a2; rr[3] = a3; rr[4] = a4;
      __syncthreads();
      if (tid < 160) { const int v = tid >> 5, c2 = tid & 31; float sum = 0; for (int g = 0; g < 16; ++g) sum += red[(g * 32 + c2) * 5 + v]; MOD[v * 6144 + u * 32 + c2] = sum + p.b_mod[u * 32 + c2]; }
    } else if (u < 320) {
      const int uu = u - 192, h = uu >> 4, k0 = (uu & 15) * 64;
      float* wt = (float*)shm; float* bs = wt + 64 * 65;
      for (int i = tid; i < 4096; i += NT) {
        const int kk = i >> 6, j = i & 63;
        wt[kk * 65 + j] = p.w_in[(size_t)(k0 + kk) * 1536 + h * 64 + j];
        const int pp = kk, mf = pp <= 32 ? pp : 64 - pp; const float ang = (float)((mf * j) & 63) * (1.0f / 32.0f);
        bs[i] = pp <= 32 ? cospif(ang) : sinpif(ang);
      }
      TLOAD();
      __syncthreads();
      for (int o = tid; o < 4096; o += NT) {
        const int kk = o & 63, pp = o >> 6; float sum = 0;
#pragma unroll 8
        for (int j = 0; j < 64; ++j) sum += wt[kk * 65 + j] * bs[pp * 64 + j];
        WIN[(size_t)(h * 64 + pp) * 1024 + k0 + kk] = (h16)sum;
      }
    } else if (u < 832) {
      const bool isout = u >= 576; const int uu = isout ? u - 576 : u - 320;
      const int n0 = (uu >> 4) * 64 + (isout ? 0 : 512), k0 = (uu & 15) * 64;
      const float* src = isout ? p.w_out : p.w_in; const int ld = isout ? 1024 : 1536;
      h16* dst = isout ? WOUT : WIN;
      float* t = (float*)shm;
      for (int i = tid; i < 4096; i += NT) { const int kk = i >> 6, nn = i & 63; t[kk * 65 + nn] = src[(size_t)(k0 + kk) * ld + n0 + nn]; }
      TLOAD();
      __syncthreads();
      for (int o = tid; o < 4096; o += NT) { const int nn = o >> 6, kk = o & 63; dst[(size_t)(n0 + nn) * 1024 + k0 + kk] = (h16)t[kk * 65 + nn]; }
    } else if (u < 1088) {
      const int uu = u - 832, g = uu >> 4, k0 = (uu & 15) * 64;
      float* q = (float*)shm; float* ky = q + 64 * 129;
      for (int i = tid; i < 64 * 128; i += NT) { const int kk = i >> 7, d = i & 127; q[kk * 129 + d] = p.peer_w_q[(size_t)(k0 + kk) * 2048 + g * 128 + d]; }
      for (int i = tid; i < 128 * 128; i += NT) { const int key = i >> 7, d = i & 127; ky[key * 129 + d] = p.peer_sub_keys[(size_t)(g * 128 + key) * 128 + d]; }
      TLOAD();
      __syncthreads();
      const int tx = tid & 15, ty = tid >> 4;
      float a[4][4] = {};
      for (int d = 0; d < 128; ++d) {
        float qv[4], kv[4];
#pragma unroll
        for (int i = 0; i < 4; ++i) { qv[i] = q[(tx * 4 + i) * 129 + d]; kv[i] = ky[(ty * 4 + i) * 129 + d]; }
#pragma unroll
        for (int ki = 0; ki < 4; ++ki)
#pragma unroll
          for (int qi = 0; qi < 4; ++qi) a[ki][qi] += kv[ki] * qv[qi];
      }
#pragma unroll
      for (int ki = 0; ki < 4; ++ki) {
        h16x4 o = {(h16)a[ki][0], (h16)a[ki][1], (h16)a[ki][2], (h16)a[ki][3]};
        *(h16x4*)(WSs + (size_t)(g * 128 + ty * 4 + ki) * 1024 + k0 + tx * 4) = o;
      }
    } else {
      f32x2* TW = (f32x2*)(p.ws + OFF_TW);
      for (int j = tid; j < 4096; j += NT) { float s, c; sincospif((float)j * (1.0f / 4096.0f), &s, &c); TW[j] = (f32x2){c, -s}; }
      TLOAD();
    }
#pragma unroll
    for (int j = 0; j < 4; ++j) tconv(rbase + j * nw0, R[j]);
  }
#undef TLOAD
  for (int row = gw0 + it * 4 * nw0; row < 32768; row += nw0) { f32x4 r[4]; tload(row, r); tconv(row, r); }
  {
    h16* WF = (h16*)(p.ws + OFF_WF); float* SP = (float*)(p.ws + OFF_SP);
    for (int i = bid * NT + tid; i < 131072; i += nb * NT) {
      const int j = i & 7, ln = (i >> 3) & 63, fragi = i >> 9;
      const int ks = fragi & 3, mt = (fragi >> 2) & 1, gate = (fragi >> 3) & 1, dh = fragi >> 4;
      const int cout = 32 * mt + (ln & 31), cin = 16 * ks + 8 * (ln >> 5) + j;
      const float* W = gate ? p.lru_w_x : p.lru_w_a;
      WF[i] = (h16)(W[((size_t)dh * 64 + cin) * 64 + cout] * -1.4426950408889634f);
    }
    for (int i = bid * NT + tid; i < 1024; i += nb * NT) {
      SP[i] = -8.0f * 1.4426950408889634f * log1pf(expf(-p.lru_lambda[i]));
      SP[1024 + i] = p.lru_b_a[i] * -1.4426950408889634f; SP[2048 + i] = p.lru_b_x[i] * -1.4426950408889634f;
    }
  }
}

DEVI void phase0b(const Params& p, char* shm, int bid, int nb) {
  const int tid = threadIdx.x, wid = tid >> 6, lane = tid & 63, gw = bid * 8 + wid, nw = nb * 8;
  const float* MOD = (const float*)(p.ws + OFF_MOD);
  h16* XS = (h16*)(p.ws + OFF_XS);
  float* RSTD1 = (float*)(p.ws + OFF_RSTD1);
  for (int tok = gw; tok < 33792; tok += nw) {
    const int bb = tok < 32768 ? (tok >> 13) : 4;
    const float* src = tok < 32768 ? p.x + (size_t)tok * 1024 : p.ctx + (size_t)(tok - 32768) * 1024;
    const float* mod = MOD + bb * 6144;
    float ss = 0;
#pragma unroll
    for (int i = 0; i < 4; ++i) {
      const int k = i * 256 + lane * 4;
      const f32x4 xv = *(const f32x4*)(src + k), g = *(const f32x4*)(p.norm1_g + k), sc = *(const f32x4*)(mod + 1024 + k);
      ss += (xv[0] * xv[0] + xv[1] * xv[1]) + (xv[2] * xv[2] + xv[3] * xv[3]);
      const f32x4 y = xv * g * (sc + 1.0f);
      h16x4 o = {(h16)y[0], (h16)y[1], (h16)y[2], (h16)y[3]};
      *(h16x4*)(XS + (size_t)tok * 1024 + k) = o;
    }
    ss = wave_sum(ss);
    if (lane == 0) RSTD1[tok] = rsqrtf(ss * (1.0f / 1024.0f) + 1e-6f);
  }
  const h16* WIN = (const h16*)(p.ws + OFF_WIN);
  const h16* WSs = (const h16*)(p.ws + OFF_WS);
  {
    h16* WSB = (h16*)(p.ws + OFF_HB);
    for (int i = bid * NT + tid; i < 2048 * 128; i += nb * NT) {
      const int n = i >> 7, k = (i & 127) * 8;
      const h16x8 w = *(const h16x8*)(WSs + (size_t)n * 1024 + k);
      const f32x4 ga = *(const f32x4*)(p.norm2_g + k), gb = *(const f32x4*)(p.norm2_g + k + 4);
#pragma unroll
      for (int b = 0; b < 4; ++b) {
        const f32x4 sa = *(const f32x4*)(MOD + b * 6144 + 4096 + k) + 1.0f, sb = *(const f32x4*)(MOD + b * 6144 + 4096 + k + 4) + 1.0f;
        h16x8 o;
#pragma unroll
        for (int j = 0; j < 4; ++j) { o[j] = (h16)((float)w[j] * ga[j] * sa[j]); o[4 + j] = (h16)((float)w[4 + j] * gb[j] * sb[j]); }
        *(h16x8*)(WSB + ((size_t)b * 2048 + n) * 1024 + k) = o;
      }
    }
  }
  float* BIAS1 = (float*)(p.ws + OFF_BIAS1);
  float* BIAS3 = (float*)(p.ws + OFF_BIAS3);
  for (int n = gw; n < 1536 + 2048; n += nw) {
    const bool is3 = n >= 1536; const int nn = is3 ? n - 1536 : n;
    const h16* wrow = (is3 ? WSs : WIN) + (size_t)nn * 1024;
    const h16x8 w0 = *(const h16x8*)(wrow + lane * 8), w1 = *(const h16x8*)(wrow + 512 + lane * 8);
    const int nv = is3 ? 4 : 5;
    for (int bb = 0; bb < nv; ++bb) {
      const float* sh = MOD + bb * 6144 + (is3 ? 3072 : 0);
      float s = 0;
#pragma unroll
      for (int j = 0; j < 8; ++j) s += (float)w0[j] * sh[lane * 8 + j] + (float)w1[j] * sh[512 + lane * 8 + j];
      s = wave_sum(s);
      if (lane == 0) { if (is3) BIAS3[bb * 2048 + nn] = s; else BIAS1[bb * 1536 + nn] = s; }
    }
  }
}

DEVI void phase1(const Params& p, char* shm, int bid, int nb) {
  const h16* XS = (const h16*)(p.ws + OFF_XS);
  const h16* WIN = (const h16*)(p.ws + OFF_WIN);
  for (int i = 0;; ++i) {
    const long L = (long)i * nb + bid; if (L >= 768) break;
    int pm, pn;
    tile_order((int)L, 128, 6, pm, pn);
    if (pn < 2) gemm_tile<1, false>(p, XS, WIN, pm, pn, shm); else gemm_tile<1, true>(p, XS, WIN, pm, pn, shm);
  }
}

typedef float f32x16 __attribute__((ext_vector_type(16)));
template <int CTRL> DEVI float dpp_old(float v, float old) {
  return __builtin_bit_cast(float, __builtin_amdgcn_update_dpp(__builtin_bit_cast(int, old), __builtin_bit_cast(int, v), CTRL, 0xf, 0xf, false));
}
template <int PAT> DEVI float swz(float v) { return __builtin_bit_cast(float, __builtin_amdgcn_ds_swizzle(__builtin_bit_cast(int, v), PAT)); }
template <int D> DEVI void scan32(float& a, float& b, int lane) {
#define LSTEP(CTRL) { const float ap = dpp_old<CTRL>(a, 1.0f), bp = dpp_old<CTRL>(b, 0.0f); b = a * bp + b; a = a * ap; }
  if (D == 0) {
    LSTEP(0x111) LSTEP(0x112) LSTEP(0x114) LSTEP(0x118)
    const float ap = __builtin_bit_cast(float, __builtin_amdgcn_update_dpp(__builtin_bit_cast(int, 1.0f), __builtin_bit_cast(int, a), 0x142, 0xa, 0xf, false));
    const float bp = __builtin_bit_cast(float, __builtin_amdgcn_update_dpp(__builtin_bit_cast(int, 0.0f), __builtin_bit_cast(int, b), 0x142, 0xa, 0xf, false));
    b = a * bp + b; a = a * ap;
  } else {
    LSTEP(0x101) LSTEP(0x102) LSTEP(0x104) LSTEP(0x108)
    float ap = swz<0x200>(a), bp = swz<0x200>(b);
    if (lane & 16) { ap = 1.0f; bp = 0.0f; }
    b = a * bp + b; a = a * ap;
  }
#undef LSTEP
}
template <int D> DEVI void scan_section(f32x16 (&aa)[2], f32x16 (&ax)[2], int lane) {
#define SSTEP(CTRL, RMASK) { _Pragma("unroll") for (int nt = 0; nt < 2; ++nt) { _Pragma("unroll") for (int r = 0; r < 16; ++r) { \
    float a_ = aa[nt][r], b_ = ax[nt][r]; \
    asm volatile("s_nop 1\n\tv_fmac_f32_dpp %0, %0, %1 " CTRL " row_mask:" RMASK " bank_mask:0xf\n\tv_mul_f32_dpp %1, %1, %1 " CTRL " row_mask:" RMASK " bank_mask:0xf" : "+v"(b_), "+v"(a_)); \
    aa[nt][r] = a_; ax[nt][r] = b_; } } }
  if (D == 0) {
    SSTEP("row_shr:1", "0xf") SSTEP("row_shr:2", "0xf") SSTEP("row_shr:4", "0xf") SSTEP("row_shr:8", "0xf") SSTEP("row_bcast:15", "0xa")
  } else {
    SSTEP("row_shl:1", "0xf") SSTEP("row_shl:2", "0xf") SSTEP("row_shl:4", "0xf") SSTEP("row_shl:8", "0xf")
#pragma unroll
    for (int nt = 0; nt < 2; ++nt)
#pragma unroll
      for (int r = 0; r < 16; ++r) {
        float ap = swz<0x200>(aa[nt][r]), bp = swz<0x200>(ax[nt][r]);
        if (lane & 16) { ap = 1.0f; bp = 0.0f; }
        ax[nt][r] = aa[nt][r] * bp + ax[nt][r]; aa[nt][r] = aa[nt][r] * ap;
      }
  }
#undef SSTEP
}
constexpr int LRU_WAVE_LDS = 18432, LRU_SSQ_OFF = 8 * LRU_WAVE_LDS;
template <int MODE>
DEVI void lru_unit(const Params& p, char* shm, int q) {
  int tid_o = threadIdx.x; asm volatile("" : "+v"(tid_o));
  const int tid = tid_o, wid = __builtin_amdgcn_readfirstlane(tid >> 6), lane = tid & 63, ch = wid * 64 + lane, half = lane >> 5, ln = lane & 31;
  const h16* UX = (const h16*)(p.ws + OFF_UX);
  h16* xh = (h16*)(shm + wid * LRU_WAVE_LDS);
  h16* hx = xh + 4608;
  float* ssq_l = (float*)(shm + LRU_SSQ_OFF);
  int tok0, lo, hi, b, jj;
  if (q < 512) { tok0 = q * 64; lo = tok0; hi = tok0 + 64; b = q >> 7; jj = 4 + (q & 127); }
  else { const int cq = q - 512; b = cq >> 2; lo = 32768 + b * 256; hi = lo + 256; tok0 = lo + (cq & 3) * 64; jj = cq & 3; }
  {
    const float cw0 = p.conv_w[ch], cw1 = p.conv_w[512 + ch], cw2 = p.conv_w[1024 + ch], cw3 = p.conv_w[1536 + ch], cb = p.conv_b[ch];
    float xv[67];
#pragma unroll
    for (int i = 0; i < 67; ++i) {
      const int tk = tok0 - 2 + i, tkc = tk < lo ? lo : (tk >= hi ? hi - 1 : tk);
      xv[i] = (float)UX[(size_t)tkc * 512 + ch];
    }
    __builtin_amdgcn_sched_barrier(0);
#pragma unroll
    for (int i = 0; i < 67; ++i) {
      const int tk = tok0 - 2 + i;
      const float msk = (tk >= lo && tk < hi) ? 1.0f : 0.0f;
      xv[i] *= msk;
    }
#pragma unroll
    for (int t = 0; t < 64; ++t) xh[t * 72 + lane] = (h16)(cb + cw0 * xv[t] + cw1 * xv[t + 1] + cw2 * xv[t + 2] + cw3 * xv[t + 3]);
  }
  h16x8 Bf[2][4];
#pragma unroll
  for (int nt = 0; nt < 2; ++nt)
#pragma unroll
    for (int ks = 0; ks < 4; ++ks) Bf[nt][ks] = *(const h16x8*)(xh + (32 * nt + ln) * 72 + 16 * ks + 8 * half);
  const h16x8* WF = (const h16x8*)(p.ws + OFF_WF);
  const float* SP = (const float*)(p.ws + OFF_SP);
  const h16* GXG = (const h16*)(p.ws + OFF_GXG);
  const float* CARRY = (const float*)(p.ws + OFF_CARRY);
  f32x2* AGG = (f32x2*)(p.ws + OFF_AGG);
  float ssq[2] = {0.0f, 0.0f};
  h16x8 WA[4], WX[4];
  {
    const h16x8* wfa = WF + ((size_t)(((1 * 8 + wid) * 2 + 0) * 8) * 64 + lane);
    const h16x8* wfx = WF + ((size_t)(((1 * 8 + wid) * 2 + 1) * 8) * 64 + lane);
#pragma unroll
    for (int ks = 0; ks < 4; ++ks) { WA[ks] = wfa[ks * 64]; WX[ks] = wfx[ks * 64]; }
  }
#pragma unroll 1
  for (int mt = 0; mt < 2; ++mt) {
#pragma unroll
    for (int dd = 0; dd < 2; ++dd) {
      const int d = 1 - dd;
      int lane_o = threadIdx.x & 63; asm volatile("" : "+v"(lane_o));
      const int lane = lane_o, half = lane >> 5, ln = lane & 31;
      f32x16 aa[2], ax[2];
      f32x4 sp4v[4];
#pragma unroll
      for (int g = 0; g < 4; ++g) {
        const int c0 = 32 * mt + 8 * g + 4 * half;
        const f32x4 ba4 = *(const f32x4*)(SP + 1024 + d * 512 + wid * 64 + c0), bx4 = *(const f32x4*)(SP + 2048 + d * 512 + wid * 64 + c0);
        sp4v[g] = *(const f32x4*)(SP + d * 512 + wid * 64 + c0);
#pragma unroll
        for (int nt = 0; nt < 2; ++nt)
#pragma unroll
          for (int j = 0; j < 4; ++j) { aa[nt][4 * g + j] = ba4[j]; ax[nt][4 * g + j] = bx4[j]; }
      }
#pragma unroll
      for (int ks = 0; ks < 4; ++ks) {
#pragma unroll
        for (int nt = 0; nt < 2; ++nt) {
          aa[nt] = __builtin_amdgcn_mfma_f32_32x32x16_f16(WA[ks], Bf[nt][ks], aa[nt], 0, 0, 0);
          ax[nt] = __builtin_amdgcn_mfma_f32_32x32x16_f16(WX[ks], Bf[nt][ks], ax[nt], 0, 0, 0);
        }
      }
      {
        const int dn = dd == 0 ? 0 : 1, mtn = dd == 0 ? mt : (mt < 1 ? mt + 1 : 1);
        const h16x8* wfa = WF + ((size_t)(((dn * 8 + wid) * 2 + 0) * 8 + mtn * 4) * 64 + lane);
        const h16x8* wfx = WF + ((size_t)(((dn * 8 + wid) * 2 + 1) * 8 + mtn * 4) * 64 + lane);
#pragma unroll
        for (int ks = 0; ks < 4; ++ks) { WA[ks] = wfa[ks * 64]; WX[ks] = wfx[ks * 64]; }
      }
#pragma unroll
      for (int g = 0; g < 4; ++g) {
        const int c0 = 32 * mt + 8 * g + 4 * half;
        const f32x4 sp4 = sp4v[g];
#pragma unroll
        for (int nt = 0; nt < 2; ++nt) {
          const h16x4 xc4 = *(const h16x4*)(xh + (32 * nt + ln) * 72 + c0);
#pragma unroll
          for (int j = 0; j < 4; ++j) {
            const int r = 4 * g + j;
            const float rg = __builtin_amdgcn_rcpf(1.0f + __builtin_amdgcn_exp2f(aa[nt][r]));
            const float ig = __builtin_amdgcn_rcpf(1.0f + __builtin_amdgcn_exp2f(ax[nt][r]));
            const float a = __builtin_amdgcn_exp2f(rg * sp4[j]);
            const float em = __builtin_fmaf(-a, a, 1.0f);
            aa[nt][r] = a; ax[nt][r] = __builtin_amdgcn_sqrtf(em) * ig * (float)xc4[j];
          }
        }
      }
      if (d) scan_section<1>(aa, ax, lane); else scan_section<0>(aa, ax, lane);
#pragma unroll
      for (int r = 0; r < 16; ++r) {
        if (d == 0) { const float ta = swz<0x3E0>(aa[0][r]), tb = swz<0x3E0>(ax[0][r]); ax[1][r] = aa[1][r] * tb + ax[1][r]; aa[1][r] = aa[1][r] * ta; }
        else        { const float ta = swz<0x000>(aa[1][r]), tb = swz<0x000>(ax[1][r]); ax[0][r] = aa[0][r] * tb + ax[0][r]; aa[0][r] = aa[0][r] * ta; }
      }
      if (MODE == 0) {
        if (ln == (d ? 0 : 31)) {
#pragma unroll
          for (int r = 0; r < 16; ++r) {
            const int c = 32 * mt + (r & 3) + 8 * (r >> 2) + 4 * half;
            AGG[((size_t)(b * 132 + jj) * 2 + d) * 512 + wid * 64 + c] = d ? (f32x2){aa[0][r], ax[0][r]} : (f32x2){aa[1][r], ax[1][r]};
          }
        }
      } else {
#pragma unroll
        for (int g = 0; g < 4; ++g) {
          const int c0 = 32 * mt + 8 * g + 4 * half;
          const f32x4 h0 = *(const f32x4*)(CARRY + ((size_t)(b * 128 + (q & 127)) * 2 + d) * 512 + wid * 64 + c0);
#pragma unroll
          for (int nt = 0; nt < 2; ++nt) {
            h16* hp = hx + (32 * nt + ln) * 72 + c0;
            f32x4 hv;
#pragma unroll
            for (int j = 0; j < 4; ++j) hv[j] = aa[nt][4 * g + j] * h0[j] + ax[nt][4 * g + j];
            if (d == 1) {
              *(h16x4*)hp = (h16x4){(h16)hv[0], (h16)hv[1], (h16)hv[2], (h16)hv[3]};
            } else {
              const h16x4 hb4 = *(const h16x4*)hp;
              const h16x4 gxh = *(const h16x4*)(GXG + (size_t)(tok0 + 32 * nt + ln) * 512 + wid * 64 + c0);
              const f32x4 gx4 = {(float)gxh[0], (float)gxh[1], (float)gxh[2], (float)gxh[3]};
              h16x4 o;
#pragma unroll
              for (int j = 0; j < 4; ++j) { const float rx = (hv[j] + (float)hb4[j]) * gx4[j]; ssq[nt] += rx * rx; o[j] = (h16)rx; }
              *(h16x4*)hp = o;
            }
          }
        }
      }
      __builtin_amdgcn_sched_barrier(0);
    }
  }
  if (MODE == 1) {
    int lane_o = threadIdx.x & 63; asm volatile("" : "+v"(lane_o));
    const int lane = lane_o, half = lane >> 5, ln = lane & 31;
#pragma unroll
    for (int nt = 0; nt < 2; ++nt) {
      const float s = ssq[nt] + __shfl_xor(ssq[nt], 32);
      if (half == 0) ssq_l[wid * 64 + 32 * nt + ln] = s;
    }
    __syncthreads();
    h16* A2 = (h16*)(p.ws + OFF_A2);
    const int cc = (lane & 7) * 8;
    const f32x4 ga = *(const f32x4*)(p.lru_out_g + wid * 64 + cc), gb = *(const f32x4*)(p.lru_out_g + wid * 64 + cc + 4);
#pragma unroll 2
    for (int i = 0; i < 8; ++i) {
      const int t = (lane >> 3) + 8 * i;
      float tot = 0;
#pragma unroll
      for (int w = 0; w < 8; ++w) tot += ssq_l[w * 64 + t];
      const float rstd = rsqrtf(tot * (1.0f / 512.0f) + 1e-6f);
      const h16x8 rv = *(const h16x8*)(hx + t * 72 + cc);
      h16x8 o;
#pragma unroll
      for (int j = 0; j < 4; ++j) { o[j] = (h16)((float)rv[j] * rstd * ga[j]); o[4 + j] = (h16)((float)rv[4 + j] * rstd * gb[j]); }
      *(h16x8*)(A2 + (size_t)(tok0 + t) * 1024 + 512 + wid * 64 + cc) = o;
    }
  }
}

DEVI void phase1b(const Params& p, char* shm, int bid, int nb);

DEVI int fpad(int i) { return i + (i >> 7); }
DEVI void phase2(const Params& p, char* shm, int bid, int nb) {
  const int tid = threadIdx.x, wid = tid >> 6, lane = tid & 63;
  if (bid < 32) {
    const int chain = bid * 2 + (wid >> 2), qtr = wid & 3;
    const int b = chain >> 4, d = (chain >> 3) & 1, ch = (chain & 7) * 64 + lane;
    const f32x2* AGG = (const f32x2*)(p.ws + OFF_AGG);
    float* CARRY = (float*)(p.ws + OFF_CARRY);
    f32x2* xq = (f32x2*)shm;
    f32x2 ab[33];
#pragma unroll
    for (int i = 0; i < 33; ++i) {
      const int s = qtr * 33 + i;
      const int j = d == 0 ? s : (s < 4 ? 3 - s : 4 + (131 - s));
      ab[i] = AGG[((size_t)(b * 132 + j) * 2 + d) * 512 + ch];
    }
    float A = 1.0f, B = 0.0f;
#pragma unroll
    for (int i = 0; i < 33; ++i) { B = ab[i][0] * B + ab[i][1]; A = ab[i][0] * A; }
    xq[wid * 64 + lane] = (f32x2){A, B};
    __syncthreads();
    float h = 0.0f;
    for (int pq = 0; pq < qtr; ++pq) { const f32x2 m = xq[((wid & 4) + pq) * 64 + lane]; h = m[0] * h + m[1]; }
#pragma unroll
    for (int i = 0; i < 33; ++i) {
      const int s = qtr * 33 + i;
      const int j = d == 0 ? s : (s < 4 ? 3 - s : 4 + (131 - s));
      if (j >= 4) CARRY[((size_t)(b * 128 + (j - 4)) * 2 + d) * 512 + ch] = h;
      h = ab[i][0] * h + ab[i][1];
    }
  }
}

DEVI void fft_units(const Params& p, char* shm, int u_lo, int u_hi, int u_step) {
  const int tid = threadIdx.x;
  f32x2* dt = (f32x2*)shm;
  f32x2* tw = (f32x2*)(shm + 68096);
  __syncthreads();
  {
    const f32x2* TW = (const f32x2*)(p.ws + OFF_TW);
    for (int j = tid; j < 4096; j += NT) tw[fpad(j)] = TW[j];
  }
  h16* GT = (h16*)(p.ws + OFF_GT);
  const float nrm = 0.0013810679320049757f;
  auto dpad = [](int i) -> int { return i + 18 * (i >> 9) + ((i >> 5) & 15); };
  auto twid = [&](int j) -> f32x2 {
    const f32x2 w = tw[fpad(j & 4095)];
    return (j & 4096) ? (f32x2){-w[0], -w[1]} : w;
  };
  for (int u = u_lo; u < u_hi; u += u_step) {
    const int b = u >> 8, h = (u >> 5) & 7, m = u & 31;
    const int s0 = m, s1 = m == 0 ? 32 : 64 - m;
    h16* g0 = GT + (size_t)(b * 512 + h * 64 + s0) * 8192;
    h16* g1 = GT + (size_t)(b * 512 + h * 64 + s1) * 8192;
    const float sg = m == 0 ? 1.0f : -1.0f;
    __syncthreads();
#pragma unroll 4
    for (int t = 2 * tid; t < 8192; t += 2 * NT) {
      const h16x2 a0 = *(const h16x2*)(g0 + t), a1 = *(const h16x2*)(g1 + t);
      dt[dpad(t)] = (f32x2){(float)a0[0], sg * (float)a1[0]}; dt[dpad(t + 1)] = (f32x2){(float)a0[1], sg * (float)a1[1]};
    }
    __syncthreads();
#pragma unroll 1
    for (int pass = 0; pass < 3; ++pass) {
      const int lgS = pass == 0 ? 9 : (pass == 1 ? 5 : 1);
      const int S = 1 << lgS;
      const int r = tid & (S - 1), base = ((tid >> lgS) << (lgS + 4)) + r;
      f32x2 x[16];
#pragma unroll
      for (int j = 0; j < 16; ++j) x[j] = dt[dpad(base + (j << lgS))];
      const float c1 = 0.9238795325112867f, s1_ = 0.3826834323650898f, c2 = 0.7071067811865476f;
#define CMULC(v, wr_, wi_) { const float tr = v[0] * (wr_) - v[1] * (wi_), ti = v[0] * (wi_) + v[1] * (wr_); v[0] = tr; v[1] = ti; }
#pragma unroll
      for (int j = 0; j < 8; ++j) { const f32x2 a = x[j], bq = x[j + 8]; x[j] = a + bq; x[j + 8] = a - bq; }
      CMULC(x[9], c1, -s1_) CMULC(x[10], c2, -c2) CMULC(x[11], s1_, -c1) { const f32x2 v = x[12]; x[12] = (f32x2){v[1], -v[0]}; }
      CMULC(x[13], -s1_, -c1) CMULC(x[14], -c2, -c2) CMULC(x[15], -c1, -s1_)
#pragma unroll
      for (int g = 0; g < 16; g += 8)
#pragma unroll
        for (int j = 0; j < 4; ++j) { const f32x2 a = x[g + j], bq = x[g + j + 4]; x[g + j] = a + bq; x[g + j + 4] = a - bq; }
#pragma unroll
      for (int g = 0; g < 16; g += 8) { CMULC(x[g + 5], c2, -c2) { const f32x2 v = x[g + 6]; x[g + 6] = (f32x2){v[1], -v[0]}; } CMULC(x[g + 7], -c2, -c2) }
#pragma unroll
      for (int g = 0; g < 16; g += 4)
#pragma unroll
        for (int j = 0; j < 2; ++j) { const f32x2 a = x[g + j], bq = x[g + j + 2]; x[g + j] = a + bq; x[g + j + 2] = a - bq; }
#pragma unroll
      for (int g = 0; g < 16; g += 4) { const f32x2 v = x[g + 3]; x[g + 3] = (f32x2){v[1], -v[0]}; }
#pragma unroll
      for (int g = 0; g < 16; g += 2) { const f32x2 a = x[g], bq = x[g + 1]; x[g] = a + bq; x[g + 1] = a - bq; }
      const int tsh = 13 - (lgS + 4);
#pragma unroll
      for (int q = 0; q < 16; ++q) {
        const int pos = ((q & 1) << 3) | ((q & 2) << 1) | ((q & 4) >> 1) | ((q & 8) >> 3);
        f32x2 v = x[pos];
        if (q) { const f32x2 w = twid((r * q) << tsh); CMULC(v, w[0], w[1]) }
        dt[dpad(base + (q << lgS))] = v;
      }
#undef CMULC
      __syncthreads();
    }
    auto rdW = [&](int k) -> f32x2 {
      const int pp = ((k & 15) << 9) + (((k >> 4) & 15) << 5) + (((k >> 8) & 15) << 1);
      const f32x2 a = dt[dpad(pp)], bq = dt[dpad(pp + 1)];
      return (k & 4096) ? a - bq : a + bq;
    };
#pragma unroll 2
    for (int k = 2 * tid; k < 8192; k += 2 * NT) {
      float y0[2], y1[2];
#pragma unroll
      for (int u2 = 0; u2 < 2; ++u2) {
        const f32x2 w1 = rdW(k + u2), w2 = rdW((8192 - (k + u2)) & 8191);
        if (m == 0) { y0[u2] = 0.5f * (w1[0] + w2[0]); y1[u2] = 0.5f * (w1[1] + w2[1]); }
        else { y0[u2] = w1[0]; y1[u2] = w2[0]; }
      }
      *(h16x2*)(g0 + k) = (h16x2){(h16)(y0[0] * nrm), (h16)(y0[1] * nrm)};
      *(h16x2*)(g1 + k) = (h16x2){(h16)(y1[0] * nrm), (h16)(y1[1] * nrm)};
    }
  }
}

DEVI void phase1b(const Params& p, char* shm, int bid, int nb) {
  const int tid = threadIdx.x;
  unsigned* flg = (unsigned*)(p.ws + OFF_BAR);
  for (int t = bid; t < 8; t += nb) {
    gemm_tile<1, true>(p, (const h16*)(p.ws + OFF_XS), (const h16*)(p.ws + OFF_WIN), 128 + (t >> 1), 2 + (t & 1), shm);
    asm volatile("s_waitcnt vmcnt(0)" ::: "memory");
    __syncthreads();
    if (tid == 0) {
      __builtin_amdgcn_fence(__ATOMIC_RELEASE, "agent");
      asm volatile("s_waitcnt vmcnt(0)" ::: "memory");
      __hip_atomic_fetch_add(flg + t, 1u, __ATOMIC_RELAXED, __HIP_MEMORY_SCOPE_AGENT);
    }
  }
  for (int q = bid; q < 528; q += nb) {
    __syncthreads();
    if (q >= 512) {
      const int b = (q - 512) >> 2;
      if (tid == 0) {
        unsigned sp = 0;
        while ((__hip_atomic_load(flg + 2 * b, __ATOMIC_RELAXED, __HIP_MEMORY_SCOPE_AGENT) == 0u ||
                __hip_atomic_load(flg + 2 * b + 1, __ATOMIC_RELAXED, __HIP_MEMORY_SCOPE_AGENT) == 0u) && ++sp < (1u << 20)) __builtin_amdgcn_s_sleep(4);
        __builtin_amdgcn_fence(__ATOMIC_ACQUIRE, "agent");
        asm volatile("s_waitcnt vmcnt(0)" ::: "memory");
      }
      __syncthreads();
    }
    lru_unit<0>(p, shm, q);
  }
  if (nb == 256) {
    int lo, cnt;
    if (bid < 8) { lo = bid; cnt = 1; } else if (bid < 16) { lo = 8 + (bid - 8) * 3; cnt = 3; } else if (bid < 48) { lo = 32 + (bid - 16) * 5; cnt = 5; } else { lo = 192 + (bid - 48) * 4; cnt = 4; }
    fft_units(p, shm, lo, lo + cnt, 1);
  } else fft_units(p, shm, bid, 1024, nb);
}

DEVI void phase3a(const Params& p, char* shm, int bid, int nb) {
  const int tid = threadIdx.x, wid = tid >> 6, lane = tid & 63;
  for (int q = bid; q < 512; q += nb) {
    __syncthreads();
    lru_unit<1>(p, shm, q);
    __syncthreads();
    int tid_o = threadIdx.x; asm volatile("" : "+v"(tid_o));
    const int wid = __builtin_amdgcn_readfirstlane(tid_o >> 6), lane = tid_o & 63;
    const int b = q >> 7, t0 = (q & 127) * 64, tok0 = q * 64;
    const h16* GT = (const h16*)(p.ws + OFF_GT);
    float* yl = (float*)shm + wid * 4160;
    float* ssq_l = (float*)shm + 8 * 4160;
    float ss = 0;
#pragma unroll 32
    for (int m = 0; m < 64; ++m) {
      const float y = (float)GT[(size_t)(b * 512 + wid * 64 + m) * 8192 + t0 + lane];
      yl[m * 65 + lane] = y; ss += y * y;
    }
    ssq_l[wid * 64 + lane] = ss;
    __syncthreads();
    h16* A2 = (h16*)(p.ws + OFF_A2);
    const int mc = (lane & 7) * 8;
    float gg[8];
#pragma unroll
    for (int jj = 0; jj < 8; ++jj) gg[jj] = p.fourier_out_g[wid * 64 + mc + jj];
    for (int i = 0; i < 8; ++i) {
      const int t = (lane >> 3) + 8 * i;
      float tot = 0;
#pragma unroll
      for (int w = 0; w < 8; ++w) tot += ssq_l[w * 64 + t];
      const float rstd = rsqrtf(tot * (1.0f / 512.0f) + 1e-6f);
      h16x8 o;
#pragma unroll
      for (int jj = 0; jj < 8; ++jj) o[jj] = (h16)(yl[(mc + jj) * 65 + t] * rstd * gg[jj]);
      *(h16x8*)(A2 + (size_t)(tok0 + t) * 1024 + wid * 64 + mc) = o;
    }
  }
}

DEVI void phase3b(const Params& p, char* shm, int bid, int nb) {
  const h16* A2 = (const h16*)(p.ws + OFF_A2);
  const h16* WOUT = (const h16*)(p.ws + OFF_WOUT);
  for (int i = 0;; ++i) {
    const long L = (long)i * nb + bid; if (L >= 512) break;
    int pm, pn; tile_order((int)L, 128, 4, pm, pn);
    gemm_tile<2, true>(p, A2, WOUT, pm, pn, shm);
  }
}
DEVI void phase3c(const Params& p, char* shm, int bid, int nb) {
  const h16* X1 = (const h16*)(p.ws + OFF_GXG);
  const h16* WSB = (const h16*)(p.ws + OFF_HB);
  for (int i = 0;; ++i) {
    const long L = (long)i * nb + bid; if (L >= 1024) break;
    int pm, pn; tile_order((int)L, 128, 8, pm, pn);
    gemm_tile<3, false>(p, X1, WSB + (size_t)(pm >> 5) * 2048 * 1024, pm, pn, shm);
  }
}

#define XB_TMO      128
#define XB_XCNT(j)  (256  + 64 * (j))
#define XB_XSUB(j)  (1280 + 64 * (j))
#define XB_XGEN(j)  (2304 + 64 * (j))
#define XB_TOP      3328
#define XB_TOPGEN   3392
#define XCD_BAR_WORDS 3456
#define XB_SPIN_CAP (1u << 18)
DEVI unsigned xb_ld(unsigned* p)              { return __hip_atomic_load(p, __ATOMIC_RELAXED, __HIP_MEMORY_SCOPE_AGENT); }
DEVI unsigned xb_add(unsigned* p, unsigned v) { return __hip_atomic_fetch_add(p, v, __ATOMIC_RELAXED, __HIP_MEMORY_SCOPE_AGENT); }
DEVI unsigned xb_xcc_id() { return (unsigned)__builtin_amdgcn_s_getreg((3 << 11) | 20) & 0xFu; }
#define XB_SPIN(cond, bar) do { unsigned _sp = 0; while (cond) { __builtin_amdgcn_s_sleep(1); \
    if ((++_sp & 255u) == 0u) { if (xb_ld(&(bar)[XB_TMO])) break; if (_sp > XB_SPIN_CAP) { atomicAdd(&(bar)[XB_TMO], 1u); break; } } } } while (0)
struct XcdBarrier { unsigned* bar; unsigned x; volatile LAS unsigned* st; };
DEVI XcdBarrier xcd_barrier_post(unsigned* bar, volatile LAS unsigned* st) {
  XcdBarrier b; b.bar = bar; b.x = xb_xcc_id(); b.st = st;
  if (threadIdx.x == 0) (void)xb_add(&bar[XB_XCNT(b.x)], 1u);
  return b;
}
DEVI void xcd_barrier_complete(unsigned* bar, unsigned x, unsigned& nloc, unsigned& nx) {
  const unsigned G = gridDim.x * gridDim.y * gridDim.z;
  unsigned sum, cnt, mine, sp = 0u;
  for (;;) {
    sum = 0u; cnt = 0u; mine = 0u;
#pragma unroll
    for (unsigned j = 0; j < 16; ++j) { const unsigned c = xb_ld(&bar[XB_XCNT(j)]); sum += c; cnt += (c > 0u) ? 1u : 0u; mine = (j == x) ? c : mine; }
    if (sum == G) break;
    __builtin_amdgcn_s_sleep(1);
    if ((++sp & 255u) == 0u) { if (xb_ld(&bar[XB_TMO])) break; if (sp > XB_SPIN_CAP) { atomicAdd(&bar[XB_TMO], 1u); break; } }
  }
  nloc = mine > 0u ? mine : 1u; nx = cnt > 0u ? cnt : 1u;
}
DEVI void xcd_barrier(const XcdBarrier& b) {
  asm volatile("s_waitcnt vmcnt(0)" ::: "memory");
  __syncthreads();
  if (threadIdx.x == 0) {
    unsigned* bar = b.bar;
    __builtin_amdgcn_s_waitcnt(0);
    unsigned nloc = b.st[0], nx = b.st[1];
    if (nloc == 0u) { xcd_barrier_complete(bar, b.x, nloc, nx); b.st[0] = nloc; b.st[1] = nx; }
    const unsigned old = xb_add(&bar[XB_XSUB(b.x)], 1u);
    const unsigned gen = old / nloc;
    if (old + 1u == (gen + 1u) * nloc) {
      __builtin_amdgcn_fence(__ATOMIC_RELEASE, "agent");
      asm volatile("s_waitcnt vmcnt(0)" ::: "memory");
      const unsigned og = xb_add(&bar[XB_TOP], 1u);
      const unsigned tg = og / nx;
      if (og + 1u == (tg + 1u) * nx) xb_add(&bar[XB_TOPGEN], 1u);
      else XB_SPIN(xb_ld(&bar[XB_TOPGEN]) == tg, bar);
      __builtin_amdgcn_fence(__ATOMIC_ACQUIRE, "agent");
      xb_add(&bar[XB_XGEN(b.x)], 1u);
      asm volatile("s_waitcnt vmcnt(0)" ::: "memory");
    } else {
      XB_SPIN(xb_ld(&bar[XB_XGEN(b.x)]) == gen, bar);
      __builtin_amdgcn_fence(__ATOMIC_ACQUIRE, "agent");
      asm volatile("s_waitcnt vmcnt(0)" ::: "memory");
    }
  }
  __syncthreads();
}

template <int XM> DEVI unsigned swz_xor(unsigned v) { return (unsigned)__builtin_amdgcn_ds_swizzle((int)v, 0x1F | (XM << 10)); }
template <int K, int J> DEVI void bitonic_step(unsigned (&x)[8], int lane) {
  if constexpr (J < 8) {
#pragma unroll
    for (int r = 0; r < 8; ++r) if ((r & J) == 0) {
      const unsigned a = x[r], b = x[r | J], mn = a < b ? a : b, mx = a < b ? b : a;
      if constexpr (K < 8) { const bool asc = (r & K) == 0; x[r] = asc ? mn : mx; x[r | J] = asc ? mx : mn; }
      else { const bool asc = K >= 512 ? true : ((lane & (K >> 3)) == 0); x[r] = asc ? mn : mx; x[r | J] = asc ? mx : mn; }
    }
  } else {
    constexpr int XL = J >> 3;
    const bool asc = K >= 512 ? true : ((lane & (K >> 3)) == 0);
    const bool lower = (lane & XL) == 0;
    const bool take_min = (asc == lower);
#pragma unroll
    for (int r = 0; r < 8; ++r) {
      unsigned o;
      if constexpr (XL < 32) o = swz_xor<XL>(x[r]); else o = (unsigned)__shfl_xor((int)x[r], 32);
      const unsigned mn = x[r] < o ? x[r] : o, mx = x[r] < o ? o : x[r];
      x[r] = take_min ? mn : mx;
    }
  }
}
template <int K, int J> DEVI void bitonic_merge(unsigned (&x)[8], int lane) {
  bitonic_step<K, J>(x, lane);
  if constexpr (J > 1) bitonic_merge<K, J / 2>(x, lane);
}
template <int K> DEVI void bitonic_sort(unsigned (&x)[8], int lane) {
  if constexpr (K > 2) bitonic_sort<K / 2>(x, lane);
  bitonic_merge<K, K / 2>(x, lane);
}

DEVI void phase3d(const Params& p, char* shm, int bid, int nb, float* const outp) {
  const int tid = threadIdx.x, wid = tid >> 6, lane = tid & 63, grp = lane >> 4, q16 = lane & 15;
  const float* MOD = (const float*)(p.ws + OFF_MOD);
  const float* SSQ2 = (const float*)(p.ws + OFF_SSQ2);
  const unsigned* TOPK = (const unsigned*)(p.ws + OFF_UX);
  const unsigned char* UB8 = (const unsigned char*)(p.ws + OFF_UB);
  const unsigned char* VB8 = (const unsigned char*)(p.ws + OFF_VB);
  const float* SU = (const float*)(p.ws + OFF_UB + 16777216);
  const float* SV = (const float*)(p.ws + OFF_VB + 16777216);
  const h16* X1 = (const h16*)(p.ws + OFF_GXG);
  char* wbase = shm + wid * 7168;
  unsigned* kl = (unsigned*)wbase; float* gl = (float*)(wbase + 2048); float* sl = (float*)(wbase + 4096);
  for (int qd = bid * 8 + wid; qd < 8192; qd += nb * 8) {
    const int tokb = qd * 4;
    const int tok = tokb + grp;
    const float* mod = MOD + (tokb >> 13) * 6144;
    {
      const int q = lane & 31, part = lane >> 5, jt = q >> 3, hd = q & 7, tk = tokb + jt;
      const u32x4* tA = (const u32x4*)(TOPK + ((size_t)tk * 16 + hd * 2 + part) * 16);
      const u32x4* tB = (const u32x4*)(TOPK + ((size_t)tk * 16 + hd * 2 + (1 - part)) * 16);
      unsigned A[16], B[16];
#pragma unroll
      for (int i = 0; i < 4; ++i) { const u32x4 a = tA[i], bq = tB[i];
#pragma unroll
        for (int c = 0; c < 4; ++c) { A[4 * i + c] = a[c]; B[4 * i + c] = bq[c]; } }
      unsigned char* ib = (unsigned char*)(wbase + 6144);
      if (part == 0) {
#pragma unroll
        for (int i = 0; i < 4; ++i) {
          ((unsigned*)ib)[q * 8 + i] = (A[4 * i] & 127u) | ((A[4 * i + 1] & 127u) << 8) | ((A[4 * i + 2] & 127u) << 16) | ((A[4 * i + 3] & 127u) << 24);
          ((unsigned*)ib)[q * 8 + 4 + i] = (B[4 * i] & 127u) | ((B[4 * i + 1] & 127u) << 8) | ((B[4 * i + 2] & 127u) << 16) | ((B[4 * i + 3] & 127u) << 24);
        }
      }
      float va[4], vb[16];
#pragma unroll
      for (int k = 0; k < 4; ++k) va[k] = key2f(A[k] & ~127u);
#pragma unroll
      for (int k = 0; k < 16; ++k) vb[k] = key2f(B[k] & ~127u);
      unsigned Lb[2][16];
      {
        int n = 0;
#pragma unroll
        for (int a = 0; a < 4; ++a)
#pragma unroll
          for (int bb = a; bb < 16; ++bb) if ((a + 1) * (bb + 1) <= 16) {
            unsigned x = (f2key(va[a] + vb[bb]) & ~511u) | (unsigned)(part << 8) | (unsigned)(a << 4) | (unsigned)bb;
            if (a == bb) x = part ? 0u : x;
            Lb[n >> 4][n & 15] = x; ++n;
          }
#pragma unroll
        for (; n < 32; ++n) Lb[n >> 4][n & 15] = 0u;
      }
#pragma unroll
      for (int k = 2; k <= 16; k <<= 1)
#pragma unroll
        for (int j = k >> 1; j >= 1; j >>= 1)
#pragma unroll
          for (int i = 0; i < 16; ++i) if ((i & j) == 0) {
            const bool desc = (i & k) == 0;
#pragma unroll
            for (int c = 0; c < 2; ++c) {
              const unsigned a = Lb[c][i], b = Lb[c][i | j], mx = umax(a, b), mn = a < b ? a : b;
              Lb[c][i] = desc ? mx : mn; Lb[c][i | j] = desc ? mn : mx;
            }
          }
      unsigned Ls[16];
#pragma unroll
      for (int k = 0; k < 16; ++k) Ls[k] = umax(Lb[0][k], Lb[1][15 - k]);
#pragma unroll
      for (int d = 8; d >= 1; d >>= 1)
#pragma unroll
        for (int k = 0; k < 16; ++k) if ((k & d) == 0) { const unsigned a = Ls[k], c2 = Ls[k + d]; Ls[k] = umax(a, c2); Ls[k + d] = a < c2 ? a : c2; }
      unsigned C[16];
#pragma unroll
      for (int k = 0; k < 16; ++k) C[k] = umax(Ls[k], (unsigned)__shfl_xor((int)Ls[15 - k], 32));
#pragma unroll
      for (int d = 8; d >= 1; d >>= 1)
#pragma unroll
        for (int k = 0; k < 16; ++k) if ((k & d) == 0) { const unsigned a = C[k], c2 = C[k + d]; C[k] = umax(a, c2); C[k + d] = a < c2 ? a : c2; }
      float ex[16]; float den = 0.0f;
      const float smax = key2f(C[0] & ~511u);
#pragma unroll
      for (int k = 0; k < 16; ++k) { ex[k] = __expf(key2f(C[k] & ~511u) - smax); den += ex[k]; }
      const float rden = 1.0f / den;
      if (part == 0) {
#pragma unroll
        for (int k = 0; k < 16; ++k) {
          const unsigned c = C[k], pp = (c >> 8) & 1u, a = (c >> 4) & 15u, bb = c & 15u;
          const unsigned i1 = pp ? bb : a, i2 = pp ? a : bb;
          const unsigned ex_id = ((unsigned)ib[q * 32 + i1] * 128u + (unsigned)ib[q * 32 + 16 + i2]);
          const int slot = jt * 128 + hd * 16 + k;
          kl[slot] = (ex_id << 9) | (unsigned)slot;
          gl[slot] = ex[k] * rden * SV[ex_id];
          sl[slot] = SU[ex_id];
        }
      }
    }
    unsigned ks[8];
    {
      const u32x4 k0 = *(const u32x4*)(kl + grp * 128 + q16 * 8), k1 = *(const u32x4*)(kl + grp * 128 + q16 * 8 + 4);
#pragma unroll
      for (int c = 0; c < 4; ++c) { ks[c] = k0[c]; ks[4 + c] = k1[c]; }
    }
    bitonic_sort<128>(ks, q16);
    int hq[16]; float sx;
    {
      const f32x4 sq = *(const f32x4*)(SSQ2 + (size_t)tok * 4);
      const float rstd2 = rsqrtf(((sq[0] + sq[1]) + (sq[2] + sq[3])) * (1.0f / 1024.0f) + 1e-6f);
      f32x4 hv[16]; float am = 0.0f;
#pragma unroll
      for (int i = 0; i < 4; ++i) {
        __builtin_amdgcn_sched_barrier(0);
#pragma unroll
        for (int c = 0; c < 4; ++c) {
          const int el = 256 * i + 16 * q16 + 4 * c;
          const h16x4 xh_ = *(const h16x4*)(X1 + (size_t)tok * 1024 + el); const f32x4 xv = {(float)xh_[0], (float)xh_[1], (float)xh_[2], (float)xh_[3]};
          const f32x4 g = *(const f32x4*)(p.norm2_g + el), sc = *(const f32x4*)(mod + 4096 + el), sh = *(const f32x4*)(mod + 3072 + el);
          const f32x4 h = xv * rstd2 * g * (sc + 1.0f) + sh;
          hv[i * 4 + c] = h;
          am = fmaxf(fmaxf(am, fmaxf(fabsf(h[0]), fabsf(h[1]))), fmaxf(fabsf(h[2]), fabsf(h[3])));
        }
      }
      __builtin_amdgcn_sched_barrier(0);
      { unsigned m = __float_as_uint(am); m = umax(m, dpp_u<0xB1>(m)); m = umax(m, dpp_u<0x4E>(m)); m = umax(m, dpp_u<0x141>(m)); m = umax(m, dpp_u<0x140>(m)); am = __uint_as_float(m); }
      const float qs = am > 0.0f ? 127.0f / am : 1.0f;
      sx = am * (1.0f / 127.0f);
#pragma unroll
      for (int k = 0; k < 16; ++k) {
        const int q0 = (int)rintf(hv[k][0] * qs), q1 = (int)rintf(hv[k][1] * qs), q2 = (int)rintf(hv[k][2] * qs), q3 = (int)rintf(hv[k][3] * qs);
        hq[k] = (int)((unsigned)(q0 & 255) | ((unsigned)(q1 & 255) << 8) | ((unsigned)(q2 & 255) << 16) | ((unsigned)(q3 & 255) << 24));
      }
    }
#define KEY_AT(RR, LL) ((unsigned)__shfl((int)ks[RR], (lane & 48) | (LL)))
#define U_LOAD(S, KEYV) { const unsigned key_ = (KEYV); \
      const unsigned char* ub_ = UB8 + (size_t)(key_ >> 9) * 1024 + q16 * 16; \
      _Pragma("unroll") for (int i = 0; i < 4; ++i) UR[S][i] = *(const u32x4*)(ub_ + 256 * i); \
      SUv[S] = sl[key_ & 511u]; GGv[S] = gl[key_ & 511u]; SLv[S] = key_ & 511u; }
#define U_COMPUTE(S) { \
      int a0_ = 0, a1_ = 0, a2_ = 0, a3_ = 0; \
      _Pragma("unroll") for (int i = 0; i < 4; ++i) { \
        a0_ = __builtin_amdgcn_sdot4((int)UR[S][i][0], hq[i * 4 + 0], a0_, false); a1_ = __builtin_amdgcn_sdot4((int)UR[S][i][1], hq[i * 4 + 1], a1_, false); \
        a2_ = __builtin_amdgcn_sdot4((int)UR[S][i][2], hq[i * 4 + 2], a2_, false); a3_ = __builtin_amdgcn_sdot4((int)UR[S][i][3], hq[i * 4 + 3], a3_, false); } \
      const float d = row_sum16((float)((a0_ + a1_) + (a2_ + a3_))) * (SUv[S] * sx); \
      const float w_ = GGv[S] * gelu_tanh_fast(d); \
      if (q16 == 0) gl[SLv[S]] = w_; }
    {
      u32x4 UR[4][4]; float SUv[4], GGv[4]; unsigned SLv[4];
      U_LOAD(0, KEY_AT(0, 0)) U_LOAD(1, KEY_AT(1, 0)) U_LOAD(2, KEY_AT(2, 0))
      unsigned keyn = KEY_AT(3, 0);
#pragma unroll 1
      for (int L = 0; L < 16; ++L) {
        const int Ln = L < 15 ? L + 1 : 15;
        if (!(L & 1)) __builtin_amdgcn_s_barrier();
#pragma unroll
        for (int r = 0; r < 8; ++r) {
          __builtin_amdgcn_sched_barrier(0);
          U_LOAD((r + 3) & 3, keyn)
          keyn = (r + 4 < 8) ? KEY_AT((r + 4) & 7, L) : KEY_AT((r + 4) & 7, Ln);
          __builtin_amdgcn_sched_barrier(0);
          U_COMPUTE(r & 3)
        }
      }
    }
#undef U_LOAD
#undef U_COMPUTE
    f32x2 acc[32];
#pragma unroll
    for (int i = 0; i < 32; ++i) acc[i] = (f32x2){0.0f, 0.0f};
#define V_LOAD(S, KEYV) { const unsigned key_ = (KEYV); \
      const unsigned char* vb_ = VB8 + (size_t)(key_ >> 9) * 1024 + q16 * 16; \
      _Pragma("unroll") for (int i = 0; i < 4; ++i) VR[S][i] = *(const u32x4*)(vb_ + 256 * i); \
      WWv[S] = gl[key_ & 511u]; }
#define V_COMPUTE(S) { const f32x2 w2 = {WWv[S], WWv[S]}; \
      _Pragma("unroll") for (int i = 0; i < 4; ++i) { \
        _Pragma("unroll") for (int c = 0; c < 4; ++c) { \
          const f32x2 lo = __builtin_amdgcn_cvt_pk_f32_fp8((int)VR[S][i][c], false), hi = __builtin_amdgcn_cvt_pk_f32_fp8((int)VR[S][i][c], true); \
          acc[i * 8 + c * 2] = __builtin_elementwise_fma(w2, lo, acc[i * 8 + c * 2]); acc[i * 8 + c * 2 + 1] = __builtin_elementwise_fma(w2, hi, acc[i * 8 + c * 2 + 1]); } } }
    {
      u32x4 VR[4][4]; float WWv[4];
      V_LOAD(0, KEY_AT(0, 0)) V_LOAD(1, KEY_AT(1, 0)) V_LOAD(2, KEY_AT(2, 0))
      unsigned keyn = KEY_AT(3, 0);
#pragma unroll 1
      for (int L = 0; L < 16; ++L) {
        const int Ln = L < 15 ? L + 1 : 15;
        if (!(L & 1)) __builtin_amdgcn_s_barrier();
#pragma unroll
        for (int r = 0; r < 8; ++r) {
          __builtin_amdgcn_sched_barrier(0);
          V_LOAD((r + 3) & 3, keyn)
          keyn = (r + 4 < 8) ? KEY_AT((r + 4) & 7, L) : KEY_AT((r + 4) & 7, Ln);
          __builtin_amdgcn_sched_barrier(0);
          V_COMPUTE(r & 3)
        }
      }
    }
#undef V_LOAD
#undef V_COMPUTE
#undef KEY_AT
    {
      f32x4 x2[16]; float ss = 0.0f;
#pragma unroll
      for (int i = 0; i < 4; ++i) {
        __builtin_amdgcn_sched_barrier(0);
#pragma unroll
        for (int c = 0; c < 4; ++c) {
          const int el = 256 * i + 16 * q16 + 4 * c;
          const h16x4 xh_ = *(const h16x4*)(X1 + (size_t)tok * 1024 + el); const f32x4 xv = {(float)xh_[0], (float)xh_[1], (float)xh_[2], (float)xh_[3]};
          const f32x4 g2 = *(const f32x4*)(mod + 5120 + el);
          const f32x4 pr = {acc[i * 8 + c * 2][0], acc[i * 8 + c * 2][1], acc[i * 8 + c * 2 + 1][0], acc[i * 8 + c * 2 + 1][1]};
          const f32x4 v = xv + g2 * pr;
          x2[i * 4 + c] = v;
          ss += (v[0] * v[0] + v[1] * v[1]) + (v[2] * v[2] + v[3] * v[3]);
        }
      }
      __builtin_amdgcn_sched_barrier(0);
      ss = row_sum16(ss);
      const float rstd = rsqrtf(ss * (1.0f / 1024.0f) + 1e-6f);
#pragma unroll
      for (int i = 0; i < 4; ++i)
#pragma unroll
        for (int c = 0; c < 4; ++c) {
          const int el = 256 * i + 16 * q16 + 4 * c;
          *(f32x4*)(outp + (size_t)tok * 1024 + el) = x2[i * 4 + c] * rstd * *(const f32x4*)(p.final_norm_g + el);
        }
    }
  }
}


__global__ void __launch_bounds__(NT) fwd_megakernel(Params p) {
  extern __shared__ __attribute__((aligned(16))) char shm[];
  cg::grid_group grid = cg::this_grid();
  const int bid = blockIdx.x, nb = gridDim.x;
  volatile LAS unsigned* xst = (volatile LAS unsigned*)(shm + LDS_USED);
  if (threadIdx.x < 4) xst[threadIdx.x] = 0u;
  __syncthreads();
  const XcdBarrier xb = xcd_barrier_post((unsigned*)(p.ws + OFF_BAR), xst);
#define GSYNC() xcd_barrier(xb)
  if (p.ws == nullptr) grid.sync();
  phase0a(p, shm, bid, nb); GSYNC();
  phase0b(p, shm, bid, nb); GSYNC();
  phase1(p, shm, bid, nb);  GSYNC();
  phase1b(p, shm, bid, nb); GSYNC();
  phase2(p, shm, bid, nb);  GSYNC();
  phase3a(p, shm, bid, nb); GSYNC();
  phase3b(p, shm, bid, nb); GSYNC();
  phase3c(p, shm, bid, nb); GSYNC();
  phase3d(p, shm, bid, nb, p.out);
}

extern "C" void kernel_launch(void* const* d_in, const int* in_sizes, int n_in, void* d_out, int out_size, void* d_ws, size_t ws_size, hipStream_t stream) {
  if (ws_size < WS_NEED) { fprintf(stderr, "workspace too small: %zu < %zu\n", ws_size, (size_t)WS_NEED); return; }
  Params p{};
  const float** pp = (const float**)&p;
  for (int i = 0; i < 24; ++i) pp[i] = (const float*)d_in[i];
  p.out = (float*)d_out; p.ws = (char*)d_ws;
  static int grid_blocks = 0;
  if (!grid_blocks) {
    hipFuncSetAttribute((const void*)fwd_megakernel, hipFuncAttributeMaxDynamicSharedMemorySize, LDS_BYTES);
    int dev = 0, cus = 0, per_cu = 0;
    hipGetDevice(&dev);
    hipDeviceGetAttribute(&cus, hipDeviceAttributeMultiprocessorCount, dev);
    hipOccupancyMaxActiveBlocksPerMultiprocessor(&per_cu, fwd_megakernel, NT, LDS_BYTES);
    if (per_cu > 1) per_cu = 1;
    grid_blocks = cus * per_cu;
  }
  (void)hipMemsetAsync((char*)d_ws + OFF_BAR, 0, 16384, stream);
  void* args[] = {&p};
  hipError_t e = hipLaunchCooperativeKernel((void*)fwd_megakernel, dim3(grid_blocks), dim3(NT), args, LDS_BYTES, stream);
  if (e != hipSuccess) fprintf(stderr, "cooperative launch failed: %s (grid %d)\n", hipGetErrorString(e), grid_blocks);
}
```

```cpp
#include <hip/hip_runtime.h>
#include <hip/hip_cooperative_groups.h>
#include <cstdio>
#include <cstdint>
namespace cg = cooperative_groups;

typedef _Float16 h16;
typedef _Float16 h16x2 __attribute__((ext_vector_type(2)));
typedef _Float16 h16x4 __attribute__((ext_vector_type(4)));
typedef _Float16 h16x8 __attribute__((ext_vector_type(8)));
typedef float f32x4 __attribute__((ext_vector_type(4)));
typedef float f32x2 __attribute__((ext_vector_type(2)));
typedef unsigned u32x4 __attribute__((ext_vector_type(4)));
typedef unsigned u32x2 __attribute__((ext_vector_type(2)));

#define DEVI __device__ __forceinline__
constexpr int NT = 512;
constexpr int LDS_USED = 151552;
constexpr int LDS_BYTES = LDS_USED + 16;

struct Params {
  const float *x, *c, *ctx, *c_ctx, *w_mod, *b_mod, *norm1_g, *w_in, *conv_w, *conv_b,
      *lru_w_a, *lru_b_a, *lru_w_x, *lru_b_x, *lru_lambda, *fourier_out_g, *lru_out_g,
      *w_out, *norm2_g, *peer_w_q, *peer_sub_keys, *peer_u, *peer_v, *final_norm_g;
  float* out;
  char* ws;
};

constexpr size_t OFF_MOD   = 0;
constexpr size_t OFF_TW    = OFF_MOD   + 122880;
constexpr size_t OFF_BIAS1 = OFF_TW    + 32768;
constexpr size_t OFF_BIAS3 = OFF_BIAS1 + 30720;
constexpr size_t OFF_RSTD1 = OFF_BIAS3 + 32768;
constexpr size_t OFF_SSQ2  = OFF_RSTD1 + 135168;
constexpr size_t OFF_AGG   = OFF_SSQ2  + 524288;
constexpr size_t OFF_CARRY = OFF_AGG   + 4325376;
constexpr size_t OFF_SP    = OFF_CARRY + 2097152;
constexpr size_t OFF_WF    = OFF_SP    + 12288;
constexpr size_t OFF_WIN   = OFF_WF    + 262144;
constexpr size_t OFF_WOUT  = OFF_WIN   + 3145728;
constexpr size_t OFF_WS    = OFF_WOUT  + 2097152;
constexpr size_t OFF_UB    = OFF_WS    + 4194304;
constexpr size_t OFF_VB    = OFF_UB    + 33554432;
constexpr size_t OFF_XS    = OFF_VB    + 33554432;
constexpr size_t OFF_GT    = OFF_XS    + 69206016;
constexpr size_t OFF_UX    = OFF_GT    + 67108864;
constexpr size_t OFF_GXG   = OFF_UX    + 69206016;
constexpr size_t OFF_HB    = OFF_GXG   + 67108864;
constexpr size_t OFF_A2    = OFF_HB    + 67108864;
constexpr size_t OFF_BAR   = OFF_A2    + 67108864;
constexpr size_t WS_NEED   = OFF_BAR   + 16384;

template <int CTRL> DEVI float dpp_f(float v) {
  return __builtin_bit_cast(float, __builtin_amdgcn_update_dpp(0, __builtin_bit_cast(int, v), CTRL, 0xf, 0xf, false));
}
template <int CTRL> DEVI unsigned dpp_u(unsigned v) {
  return (unsigned)__builtin_amdgcn_update_dpp(0, (int)v, CTRL, 0xf, 0xf, false);
}
DEVI float row_sum16(float v) {
  v += dpp_f<0xB1>(v); v += dpp_f<0x4E>(v); v += dpp_f<0x141>(v); v += dpp_f<0x140>(v); return v;
}
DEVI float rl_f(float v, int l) { return __builtin_bit_cast(float, __builtin_amdgcn_readlane(__builtin_bit_cast(int, v), l)); }
DEVI float wave_sum(float v) {
  v = row_sum16(v);
  return (rl_f(v, 0) + rl_f(v, 16)) + (rl_f(v, 32) + rl_f(v, 48));
}
DEVI unsigned umax(unsigned a, unsigned b) { return a > b ? a : b; }
DEVI unsigned wave_max_u(unsigned v) {
  v = umax(v, dpp_u<0xB1>(v)); v = umax(v, dpp_u<0x4E>(v)); v = umax(v, dpp_u<0x141>(v)); v = umax(v, dpp_u<0x140>(v));
  unsigned a = (unsigned)__builtin_amdgcn_readlane((int)v, 0), b = (unsigned)__builtin_amdgcn_readlane((int)v, 16);
  unsigned c = (unsigned)__builtin_amdgcn_readlane((int)v, 32), d = (unsigned)__builtin_amdgcn_readlane((int)v, 48);
  return umax(umax(a, b), umax(c, d));
}
DEVI float gelu_tanh_fast(float x) {
  const float u = 0.7978845608028654f * (x + 0.044715f * x * x * x);
  const float e = __builtin_amdgcn_exp2f(u * 2.8853900817779268f);
  const float t = 1.0f - 2.0f * __builtin_amdgcn_rcpf(1.0f + e);
  return 0.5f * x * (1.0f + t);
}
DEVI float gelu_tanh(float x) {
  float u = 0.7978845608028654f * (x + 0.044715f * x * x * x);
  float e = __expf(2.0f * u);
  float t = 1.0f - 2.0f / (1.0f + e);
  return 0.5f * x * (1.0f + t);
}
DEVI float sigmoidf_(float x) { return 1.0f / (1.0f + __expf(-x)); }
DEVI unsigned f2key(float f) { const unsigned u = __float_as_uint(f); return u ^ ((unsigned)((int)u >> 31) | 0x80000000u); }
DEVI float key2f(unsigned k) { unsigned u = (k & 0x80000000u) ? (k & 0x7fffffffu) : ~k; return __uint_as_float(u); }

DEVI u32x4 pair_rows8(const h16x4 v0, const h16x4 v1) {
  const u32x2 a = __builtin_bit_cast(u32x2, v0), b = __builtin_bit_cast(u32x2, v1);
  const u32x2 r0 = __builtin_amdgcn_permlane16_swap(a[0], b[0], false, false), r1 = __builtin_amdgcn_permlane16_swap(a[1], b[1], false, false);
  return (u32x4){r0[0], r1[0], r0[1], r1[1]};
}
constexpr int BM = 256, BK = 64, HALF = 128, HT = HALF * BK, KD = 1024;
DEVI int lds_byte(int r, int c) {
  int st = (r >> 4) * 2 + (c >> 5), rr = r & 15, cc = c & 31, ob = rr * 64 + cc * 2;
  return st * 1024 + (ob ^ (((ob >> 9) & 1) << 5));
}
DEVI void stage_rc(int b, int& R, int& C) {
  int st = b / 1024, sb = b % 1024, swz = sb ^ (((sb >> 9) & 1) << 5);
  R = (st >> 1) * 16 + swz / 64; C = (st & 1) * 32 + (swz % 64) / 2;
}
DEVI void tile_order(int L, int nM, int nN, int& pm, int& pn) {
  int nwg = nM * nN, wgid = L;
  { int q = nwg / 8, r = nwg % 8, xcd = wgid % 8, off = wgid / 8; wgid = (xcd < r ? xcd * (q + 1) : r * (q + 1) + (xcd - r) * q) + off; }
  int nig = 8 * nN, gid = wgid / nig, fm = gid * 8, gsz = (nM - fm) < 8 ? (nM - fm) : 8;
  pm = fm + ((wgid % nig) % gsz); pn = (wgid % nig) / gsz;
}

#define LAS __attribute__((address_space(3)))
constexpr int HTB = HALF * BK * 2;
template <int EPI, bool TRANS>
DEVI void gemm_tile(const Params& p, const h16* __restrict__ A, const h16* __restrict__ Bt, int pm, int pn, char* shmc) {
  LAS unsigned char* lds = (LAS unsigned char*)shmc;
  int tid_k = threadIdx.x; asm volatile("" : "+v"(tid_k));
  const int tid = tid_k;
  const int brow = pm * BM, bcol = pn * BM;
  const int wid = tid >> 6, lane = tid & 63, wr = wid >> 2, wc = wid & 3, fr = lane & 15, fq = lane >> 4;
  unsigned voff[2];
#pragma unroll
  for (int i = 0; i < 2; ++i) { int R, C; stage_rc(tid * 16 + i * 8192, R, C); voff[i] = (unsigned)(R * KD + C) * 2u; }
  constexpr size_t kstep = (size_t)(BK * 2), hstep = (size_t)HALF * KD * 2;
  const unsigned ldsw = (unsigned)wid * 1024u;
  const int aoff = lds_byte(wr * 64 + fr, fq * 8), boff = lds_byte(wc * 32 + fr, fq * 8);
  const char* cA = (const char*)A + (size_t)brow * KD * 2;
  const char* cB = (const char*)Bt + (size_t)bcol * KD * 2;
#define SA(b, h) (((b) * 2 + (h)) * HTB)
#define SB(b, h) ((4 + (b) * 2 + (h)) * HTB)
#define STAGE(bufoff, gbase) do { _Pragma("unroll") for (int _i = 0; _i < 2; ++_i) \
    __builtin_amdgcn_global_load_lds((const unsigned*)((const char*)(gbase) + voff[_i]), (LAS unsigned*)(lds + (bufoff) + ldsw + _i * 8192), 16, 0, 0); } while (0)
#define LDA(dst, b, h) do { _Pragma("unroll") for (int m = 0; m < 4; ++m) _Pragma("unroll") for (int k = 0; k < 2; ++k) dst[m][k] = *(const LAS h16x8*)(lds + SA(b, h) + aoff + m * 2048 + k * 1024); } while (0)
#define LDB(dst, b, h) do { _Pragma("unroll") for (int n = 0; n < 2; ++n) _Pragma("unroll") for (int k = 0; k < 2; ++k) dst[n][k] = *(const LAS h16x8*)(lds + SB(b, h) + boff + n * 2048 + k * 1024); } while (0)
#define MMA(ai, bj, At_, Bt_) do { __builtin_amdgcn_s_setprio(1); _Pragma("unroll") for (int m = 0; m < 4; ++m) _Pragma("unroll") for (int n = 0; n < 2; ++n) _Pragma("unroll") for (int k = 0; k < 2; ++k) \
      acc[ai][bj][m][n] = TRANS ? __builtin_amdgcn_mfma_f32_16x16x32_f16(Bt_[n][k], At_[m][k], acc[ai][bj][m][n], 0, 0, 0) \
                                : __builtin_amdgcn_mfma_f32_16x16x32_f16(At_[m][k], Bt_[n][k], acc[ai][bj][m][n], 0, 0, 0); \
    __builtin_amdgcn_s_setprio(0); } while (0)
#define WAIT_V(n) asm volatile("s_waitcnt vmcnt(" #n ")" ::: "memory")
#define WAIT_L(n) asm volatile("s_waitcnt lgkmcnt(" #n ")" ::: "memory")
#define BAR __builtin_amdgcn_s_barrier()
#define SCHED __builtin_amdgcn_sched_barrier(0)
  f32x4 acc[2][2][4][2];
#pragma unroll
  for (int a = 0; a < 2; ++a)
#pragma unroll
    for (int b = 0; b < 2; ++b)
#pragma unroll
      for (int m = 0; m < 4; ++m)
#pragma unroll
        for (int n = 0; n < 2; ++n) acc[a][b][m][n] = (f32x4){0.f, 0.f, 0.f, 0.f};
  h16x8 At[4][2], B0[2][2], B1[2][2];
  constexpr int nt = KD / BK;
  STAGE(SB(0, 0), cB); STAGE(SA(0, 0), cA); STAGE(SB(0, 1), cB + hstep); STAGE(SA(0, 1), cA + hstep);
  if (wr == 1) BAR;
  WAIT_V(4); BAR;
  STAGE(SB(1, 0), cB + kstep); STAGE(SA(1, 0), cA + kstep); STAGE(SB(1, 1), cB + hstep + kstep);
  WAIT_V(6); BAR;
#pragma unroll 1
  for (int t = 0; t < nt - 2; t += 2) {
    const char* a1 = cA + (size_t)(t + 1) * kstep;
    const char* a2 = cA + (size_t)(t + 2) * kstep; const char* b2 = cB + (size_t)(t + 2) * kstep;
    const char* a3 = a2 + kstep; const char* b3 = b2 + kstep;
    LDB(B0, 0, 0); SCHED; LDA(At, 0, 0); STAGE(SA(1, 1), a1 + hstep);
    WAIT_L(8); BAR; WAIT_L(0); MMA(0, 0, At, B0); BAR; SCHED;
    LDB(B1, 0, 1); STAGE(SB(0, 0), b2);
    BAR; WAIT_L(0); MMA(0, 1, At, B1); BAR;
    LDA(At, 0, 1); STAGE(SA(0, 0), a2);
    BAR; WAIT_L(0); MMA(1, 0, At, B0); BAR; SCHED;
    STAGE(SB(0, 1), b2 + hstep);
    WAIT_V(6); BAR; MMA(1, 1, At, B1); BAR;
    LDB(B0, 1, 0); SCHED; LDA(At, 1, 0); STAGE(SA(0, 1), a2 + hstep);
    WAIT_L(8); BAR; WAIT_L(0); MMA(0, 0, At, B0); BAR; SCHED;
    LDB(B1, 1, 1); STAGE(SB(1, 0), b3);
    BAR; WAIT_L(0); MMA(0, 1, At, B1); BAR;
    LDA(At, 1, 1); STAGE(SA(1, 0), a3);
    BAR; WAIT_L(0); MMA(1, 0, At, B0); BAR; SCHED;
    STAGE(SB(1, 1), b3 + hstep);
    WAIT_V(6); BAR; MMA(1, 1, At, B1); BAR;
  }
  { LDB(B0, 0, 0); LDA(At, 0, 0); STAGE(SA(1, 1), cA + (size_t)(nt - 1) * kstep + hstep);
    BAR; WAIT_L(0); MMA(0, 0, At, B0); BAR;
    LDB(B1, 0, 1); BAR; WAIT_L(0); MMA(0, 1, At, B1); BAR;
    LDA(At, 0, 1); WAIT_V(4); BAR; WAIT_L(0); MMA(1, 0, At, B0); MMA(1, 1, At, B1); BAR; }
  { LDB(B0, 1, 0); LDA(At, 1, 0); WAIT_V(2); BAR; WAIT_L(0); MMA(0, 0, At, B0); BAR;
    LDB(B1, 1, 1); WAIT_V(0); BAR; WAIT_L(0); MMA(0, 1, At, B1); BAR;
    LDA(At, 1, 1); BAR; WAIT_L(0); MMA(1, 0, At, B0); MMA(1, 1, At, B1); BAR; }
  if (wr == 0) BAR;
#undef SA
#undef SB
#undef STAGE
#undef LDA
#undef LDB
#undef MMA
  int tid_e = threadIdx.x; asm volatile("" : "+v"(tid_e));
  {
  const int tid = tid_e, wid = tid >> 6, lane = tid & 63, wr = wid >> 2, wc = wid & 3, fr = lane & 15, fq = lane >> 4;
  (void)lane; (void)wr; (void)wc; (void)fr; (void)fq;
  if constexpr (EPI == 1) {
    const float* RSTD1 = (const float*)(p.ws + OFF_RSTD1);
    const float* BIAS1 = (const float*)(p.ws + OFF_BIAS1);
    const int bb = brow < 32768 ? (brow >> 13) : 4;
    if constexpr (!TRANS) {
      h16* GT = (h16*)(p.ws + OFF_GT);
      f32x4 rsv[2][4]; float biasv[2][2];
#pragma unroll
      for (int ai = 0; ai < 2; ++ai)
#pragma unroll
        for (int m = 0; m < 4; ++m) rsv[ai][m] = *(const f32x4*)(RSTD1 + brow + ai * 128 + wr * 64 + m * 16 + fq * 4);
#pragma unroll
      for (int bj = 0; bj < 2; ++bj)
#pragma unroll
        for (int n = 0; n < 2; ++n) biasv[bj][n] = BIAS1[bb * 1536 + bcol + bj * 128 + wc * 32 + n * 16 + fr];
      __builtin_amdgcn_sched_barrier(0);
#pragma unroll
      for (int ai = 0; ai < 2; ++ai)
#pragma unroll
        for (int m = 0; m < 4; ++m) {
          const int row0 = brow + ai * 128 + wr * 64 + m * 16 + fq * 4;
          const f32x4 rs = rsv[ai][m];
#pragma unroll
          for (int bj = 0; bj < 2; ++bj)
#pragma unroll
            for (int n = 0; n < 2; ++n) {
              const int col = bcol + bj * 128 + wc * 32 + n * 16 + fr;
              const float bias = biasv[bj][n];
              const f32x4 gv = acc[ai][bj][m][n] * rs + bias;
              *(h16x4*)(GT + ((size_t)(bb * 512 + col) * 8192 + (row0 & 8191))) = (h16x4){(h16)gv[0], (h16)gv[1], (h16)gv[2], (h16)gv[3]};
            }
        }
    } else {
      h16* UX = (h16*)(p.ws + OFF_UX);
      h16* GXG = (h16*)(p.ws + OFF_GXG);
      float rsv[2][4]; f32x4 biasv[2][2];
#pragma unroll
      for (int ai = 0; ai < 2; ++ai)
#pragma unroll
        for (int m = 0; m < 4; ++m) rsv[ai][m] = RSTD1[brow + ai * 128 + wr * 64 + m * 16 + fr];
#pragma unroll
      for (int bj = 0; bj < 2; ++bj)
#pragma unroll
        for (int n = 0; n < 2; ++n) biasv[bj][n] = *(const f32x4*)(BIAS1 + bb * 1536 + bcol + bj * 128 + wc * 32 + n * 16 + fq * 4);
      __builtin_amdgcn_sched_barrier(0);
#pragma unroll
      for (int ai = 0; ai < 2; ++ai)
#pragma unroll
        for (int m = 0; m < 4; ++m) {
          const int row = brow + ai * 128 + wr * 64 + m * 16 + fr;
          const float rs = rsv[ai][m];
#pragma unroll
          for (int bj = 0; bj < 2; ++bj) {
            h16x4 hv2[2];
#pragma unroll
            for (int n = 0; n < 2; ++n) {
              f32x4 v = acc[ai][bj][m][n] * rs + biasv[bj][n];
              if (pn >= 4) { v[0] = gelu_tanh_fast(v[0]); v[1] = gelu_tanh_fast(v[1]); v[2] = gelu_tanh_fast(v[2]); v[3] = gelu_tanh_fast(v[3]); }
              hv2[n] = (h16x4){(h16)v[0], (h16)v[1], (h16)v[2], (h16)v[3]};
            }
            const int col8 = bcol + bj * 128 + wc * 32 + (fq & 1) * 16 + (fq >> 1) * 8;
            const u32x4 o8 = pair_rows8(hv2[0], hv2[1]);
            if (pn < 4) *(u32x4*)(UX + (size_t)row * 512 + (col8 - 512)) = o8; else *(u32x4*)(GXG + (size_t)row * 512 + (col8 - 1024)) = o8;
          }
        }
    }
  } else if constexpr (EPI == 2) {
    static_assert(EPI != 2 || TRANS, "EPI 2 uses transposed accumulators");
    const float* MOD = (const float*)(p.ws + OFF_MOD);
    float* SSQ2 = (float*)(p.ws + OFF_SSQ2);
    h16* X1 = (h16*)(p.ws + OFF_GXG);
    float* red = (float*)shmc;
    const int b = brow >> 13;
    f32x4 g1v[2][2];
#pragma unroll
    for (int bj = 0; bj < 2; ++bj)
#pragma unroll
      for (int n = 0; n < 2; ++n) g1v[bj][n] = *(const f32x4*)(MOD + b * 6144 + 2048 + bcol + wc * 64 + bj * 32 + n * 16 + fq * 4);
#pragma unroll
    for (int ai = 0; ai < 2; ++ai) {
      f32x4 xv[4][2][2];
#pragma unroll
      for (int mm = 0; mm < 4; ++mm)
#pragma unroll
        for (int bj = 0; bj < 2; ++bj)
#pragma unroll
          for (int n = 0; n < 2; ++n)
            xv[mm][bj][n] = *(const f32x4*)(p.x + (size_t)(brow + ai * 128 + wr * 64 + mm * 16 + fr) * 1024 + bcol + wc * 64 + bj * 32 + n * 16 + fq * 4);
      __builtin_amdgcn_sched_barrier(0);
#pragma unroll
      for (int mm = 0; mm < 4; ++mm) {
        const int m = mm;
        const int row = brow + ai * 128 + wr * 64 + m * 16 + fr;
        float ss = 0.0f;
#pragma unroll
        for (int bj = 0; bj < 2; ++bj) {
          h16x4 hx2[2];
#pragma unroll
          for (int n = 0; n < 2; ++n) {
            const f32x4 x1 = xv[mm][bj][n] + g1v[bj][n] * acc[ai][bj][m][n];
            hx2[n] = (h16x4){(h16)x1[0], (h16)x1[1], (h16)x1[2], (h16)x1[3]};
            ss += (x1[0] * x1[0] + x1[1] * x1[1]) + (x1[2] * x1[2] + x1[3] * x1[3]);
          }
          *(u32x4*)(X1 + (size_t)row * 1024 + bcol + wc * 64 + bj * 32 + (fq & 1) * 16 + (fq >> 1) * 8) = pair_rows8(hx2[0], hx2[1]);
        }
        ss += __shfl_xor(ss, 16); ss += __shfl_xor(ss, 32);
        if (fq == 0) red[wc * 256 + ai * 128 + wr * 64 + m * 16 + fr] = ss;
      }
    }
    __syncthreads();
    if (tid < 256) {
      const int r = tid;
      SSQ2[(size_t)(brow + r) * 4 + pn] = (red[r] + red[256 + r]) + (red[512 + r] + red[768 + r]);
    }
  } else if constexpr (EPI == 3) {
    const float* SSQ2 = (const float*)(p.ws + OFF_SSQ2);
    const float* BIAS3 = (const float*)(p.ws + OFF_BIAS3);
    unsigned* TOPK = (unsigned*)(p.ws + OFF_UX);
    float* sc = (float*)shmc;
    float* rstd_l = (float*)(shmc + 139264);
    const int b = brow >> 13;
    if (tid < 256) {
      const f32x4 q = *(const f32x4*)(SSQ2 + (size_t)(brow + tid) * 4);
      rstd_l[tid] = rsqrtf(((q[0] + q[1]) + (q[2] + q[3])) * (1.0f / 1024.0f) + 1e-6f);
    }
#pragma unroll
    for (int bj = 0; bj < 2; ++bj) {
      __syncthreads();
      float bias3v[2];
#pragma unroll
      for (int n = 0; n < 2; ++n) bias3v[n] = BIAS3[b * 2048 + bcol + bj * 128 + wc * 32 + n * 16 + fr];
#pragma unroll
      for (int ai = 0; ai < 2; ++ai)
#pragma unroll
        for (int m = 0; m < 4; ++m) {
          const int r0 = ai * 128 + wr * 64 + m * 16 + fq * 4;
          const f32x4 rstd = *(const f32x4*)(rstd_l + r0);
#pragma unroll
          for (int n = 0; n < 2; ++n) {
            const int cl = wc * 32 + n * 16 + fr;
            const float bias = bias3v[n];
            const int cls = cl ^ ((fq & 1) << 4);
            const int pc = cls + 4 * (cls >> 6);
#pragma unroll
            for (int j = 0; j < 4; ++j) sc[(r0 + j) * 136 + pc] = acc[ai][bj][m][n][j] * rstd[j] + bias;
          }
        }
      __syncthreads();
      {
        const int row = tid >> 1, hf = tid & 1;
        const float* rp = sc + row * 136 + hf * 68;
        const int sw4 = ((row >> 2) & 1) * 16;
        const float* rpA = rp + sw4; const float* rpB = rp - sw4;
        unsigned Lq[4][16];
#pragma unroll
        for (int i4 = 0; i4 < 4; ++i4) {
          f32x4 v[4];
#pragma unroll
          for (int c = 0; c < 4; ++c) v[c] = *(const f32x4*)((c & 1 ? rpB : rpA) + (c * 4 + i4) * 4);
#pragma unroll
          for (int j = 0; j < 4; ++j)
#pragma unroll
            for (int c = 0; c < 4; ++c) Lq[c][i4 * 4 + j] = (f2key(v[c][j]) & ~127u) | (unsigned)(hf * 64 + (c * 4 + i4) * 4 + j);
        }
#pragma unroll
        for (int k = 2; k <= 16; k <<= 1)
#pragma unroll
          for (int j = k >> 1; j >= 1; j >>= 1)
#pragma unroll
            for (int i = 0; i < 16; ++i) if ((i & j) == 0) {
              const bool desc = (i & k) == 0;
#pragma unroll
              for (int c = 0; c < 4; ++c) {
                const unsigned a = Lq[c][i], b = Lq[c][i | j], mx = umax(a, b), mn = a < b ? a : b;
                Lq[c][i] = desc ? mx : mn; Lq[c][i | j] = desc ? mn : mx;
              }
            }
        auto merge16 = [](unsigned (&A)[16], const unsigned (&B)[16]) {
#pragma unroll
          for (int k = 0; k < 16; ++k) A[k] = umax(A[k], B[15 - k]);
#pragma unroll
          for (int d = 8; d >= 1; d >>= 1)
#pragma unroll
            for (int k = 0; k < 16; ++k) if ((k & d) == 0) { const unsigned a = A[k], c2 = A[k + d]; A[k] = umax(a, c2); A[k + d] = a < c2 ? a : c2; }
        };
        merge16(Lq[0], Lq[1]); merge16(Lq[2], Lq[3]); merge16(Lq[0], Lq[2]);
        unsigned (&L)[16] = Lq[0];
        unsigned C[16];
#pragma unroll
        for (int k = 0; k < 16; ++k) C[k] = umax(L[k], dpp_u<0xB1>(L[15 - k]));
#pragma unroll
        for (int d = 8; d >= 1; d >>= 1)
#pragma unroll
          for (int k = 0; k < 16; ++k) if ((k & d) == 0) { const unsigned a = C[k], c2 = C[k + d]; C[k] = umax(a, c2); C[k + d] = a < c2 ? a : c2; }
        unsigned* dst = TOPK + ((size_t)(brow + row) * 16 + (pn * 2 + bj)) * 16;
        if (hf == 0) { *(u32x4*)dst = (u32x4){C[0], C[1], C[2], C[3]}; *(u32x4*)(dst + 4) = (u32x4){C[4], C[5], C[6], C[7]}; }
        else { *(u32x4*)(dst + 8) = (u32x4){C[8], C[9], C[10], C[11]}; *(u32x4*)(dst + 12) = (u32x4){C[12], C[13], C[14], C[15]}; }
      }
    }
  }
  }
  __syncthreads();
}

DEVI void phase0a(const Params& p, char* shm, int bid, int nb) {
  const int tid = threadIdx.x;
  float* MOD = (float*)(p.ws + OFF_MOD);
  h16* WIN = (h16*)(p.ws + OFF_WIN);
  h16* WOUT = (h16*)(p.ws + OFF_WOUT);
  h16* WSs = (h16*)(p.ws + OFF_WS);
  for (int u = bid; u < 193; u += nb) {
   {
    __syncthreads();
    if (u < 192) {
      float* s = (float*)shm; float* red = s + 5120;
      for (int i = tid; i < 5120; i += NT) { const int v = i >> 10, k = i & 1023; const float xv = v < 4 ? p.c[v * 1024 + k] : p.c_ctx[k]; s[i] = xv / (1.0f + expf(-xv)); }
      __syncthreads();
      const int c4 = tid & 7, kg = tid >> 3;
      f32x4 wv[16];
#pragma unroll
      for (int i = 0; i < 16; ++i) wv[i] = *(const f32x4*)(p.w_mod + (size_t)(kg + 64 * i) * 6144 + u * 32 + c4 * 4);
      f32x4 a0 = {0.f, 0.f, 0.f, 0.f}, a1 = a0, a2 = a0, a3 = a0, a4 = a0;
#pragma unroll
      for (int i = 0; i < 16; ++i) { const int k = kg + 64 * i; a0 += wv[i] * s[k]; a1 += wv[i] * s[1024 + k]; a2 += wv[i] * s[2048 + k]; a3 += wv[i] * s[3072 + k]; a4 += wv[i] * s[4096 + k]; }
      float* rr = red + kg * 160 + c4 * 4;
      *(f32x4*)(rr) = a0; *(f32x4*)(rr + 32) = a1; *(f32x4*)(rr + 64) = a2; *(f32x4*)(rr + 96) = a3; *(f32x4*)(rr + 128) = a4;
      __syncthreads();
      if (tid < 160) { float sum = 0; for (int g = 0; g < 64; ++g) sum += red[g * 160 + tid]; const int v = tid >> 5, c2 = tid & 31; MOD[v * 6144 + u * 32 + c2] = sum + p.b_mod[u * 32 + c2]; }
    } else {
      f32x2* TW = (f32x2*)(p.ws + OFF_TW);
      for (int j = tid; j < 4096; j += NT) { float s, c; sincospif((float)j * (1.0f / 4096.0f), &s, &c); TW[j] = (f32x2){c, -s}; }
    }
   }
  }
  {
    float* tab = (float*)shm;
    __syncthreads();
    { int t0 = threadIdx.x; asm volatile("" : "+v"(t0)); if (t0 < 64) tab[t0] = cospif((float)t0 * (1.0f / 32.0f)); }
    __syncthreads();
    int tq = threadIdx.x; asm volatile("" : "+v"(tq));
    const int lane = tq & 63, gw = bid * 8 + (tq >> 6), nw = nb * 8, fr = lane & 15, fq = lane >> 4;
    for (int wu = gw; wu < 2048; wu += nw) {
      const int h = wu >> 8, pt = (wu >> 6) & 3, kt = wu & 63;
      const int pp = pt * 16 + fr, mf = pp <= 32 ? pp : 64 - pp, sh = pp <= 32 ? 0 : 48;
      const float* wa = p.w_in + (size_t)(kt * 16 + fr) * 1536 + h * 64 + fq * 8;
      f32x4 ah = {0.f, 0.f, 0.f, 0.f}, al = ah;
#pragma unroll
      for (int ks = 0; ks < 2; ++ks) {
        const f32x4 q0 = *(const f32x4*)(wa + ks * 32), q1 = *(const f32x4*)(wa + ks * 32 + 4);
        h16x8 Ah, Al, Bh, Bl;
#pragma unroll
        for (int j = 0; j < 4; ++j) {
          Ah[j] = (h16)q0[j]; Al[j] = (h16)((q0[j] - (float)Ah[j]) * 2048.0f);
          Ah[4 + j] = (h16)q1[j]; Al[4 + j] = (h16)((q1[j] - (float)Ah[4 + j]) * 2048.0f);
        }
#pragma unroll
        for (int i = 0; i < 8; ++i) {
          const float bv = tab[(mf * (ks * 32 + fq * 8 + i) + sh) & 63];
          Bh[i] = (h16)bv; Bl[i] = (h16)((bv - (float)Bh[i]) * 2048.0f);
        }
        ah = __builtin_amdgcn_mfma_f32_16x16x32_f16(Ah, Bh, ah, 0, 0, 0);
        al = __builtin_amdgcn_mfma_f32_16x16x32_f16(Ah, Bl, al, 0, 0, 0);
        al = __builtin_amdgcn_mfma_f32_16x16x32_f16(Al, Bh, al, 0, 0, 0);
      }
      const f32x4 v = ah + al * (1.0f / 2048.0f);
      *(h16x4*)(WIN + (size_t)(h * 64 + pp) * 1024 + kt * 16 + fq * 4) = (h16x4){(h16)v[0], (h16)v[1], (h16)v[2], (h16)v[3]};
    }
  }
  {
    int tq = threadIdx.x; asm volatile("" : "+v"(tq));
    const int lane = tq & 63, gw = bid * 8 + (tq >> 6), nw = nb * 8, fr = lane & 15, fq = lane >> 4;
    h16x8 I0, I1;
#pragma unroll
    for (int i = 0; i < 8; ++i) { I0[i] = (fq * 8 + i == fr) ? (h16)1.0f : (h16)0.0f; I1[i] = (fq * 8 + i == fr + 16) ? (h16)1.0f : (h16)0.0f; }
    for (int wu = gw; wu < 2048; wu += nw) {
      const bool isout = wu >= 1024; const int r = wu & 1023, nb32 = r >> 5, kb32 = r & 31;
      const float* src = isout ? p.w_out : p.w_in; const int ld = isout ? 1024 : 1536, sc0 = nb32 * 32 + (isout ? 0 : 512);
      const int rb0 = isout ? (nb32 >> 3) * 256 + (nb32 & 1) * 128 + ((nb32 >> 1) & 3) * 32 : sc0;
      h16* dst = (isout ? WOUT : WIN) + (size_t)(rb0 + fr) * 1024 + kb32 * 32 + fq * 4;
#pragma unroll
      for (int m = 0; m < 2; ++m) {
        const float* a = src + (size_t)(kb32 * 32 + m * 16 + fr) * ld + sc0 + fq * 8;
        const f32x4 q0 = *(const f32x4*)a, q1 = *(const f32x4*)(a + 4);
        const h16x8 Ah = {(h16)q0[0], (h16)q0[1], (h16)q0[2], (h16)q0[3], (h16)q1[0], (h16)q1[1], (h16)q1[2], (h16)q1[3]};
        const f32x4 z = {0.f, 0.f, 0.f, 0.f};
        const f32x4 d0 = __builtin_amdgcn_mfma_f32_16x16x32_f16(Ah, I0, z, 0, 0, 0);
        const f32x4 d1 = __builtin_amdgcn_mfma_f32_16x16x32_f16(Ah, I1, z, 0, 0, 0);
        *(h16x4*)(dst + m * 16) = (h16x4){(h16)d0[0], (h16)d0[1], (h16)d0[2], (h16)d0[3]};
        *(h16x4*)(dst + 16 * 1024 + m * 16) = (h16x4){(h16)d1[0], (h16)d1[1], (h16)d1[2], (h16)d1[3]};
      }
    }
  }
  {
    int tq = threadIdx.x; asm volatile("" : "+v"(tq));
    const int lane = tq & 63, gw = bid * 8 + (tq >> 6), nw = nb * 8, fr = lane & 15, fq = lane >> 4;
    for (int wu = gw; wu < 2048; wu += nw) {
      const int g = wu >> 7, kb = (wu >> 5) & 3, kc = wu & 31;
      const float* qa = p.peer_w_q + (size_t)(kc * 32 + fr) * 2048 + g * 128 + fq * 8;
      const float* ka = p.peer_sub_keys + (size_t)(g * 128 + kb * 32 + fr) * 128 + fq * 8;
      f32x4 ah[2][2], al[2][2];
#pragma unroll
      for (int m = 0; m < 2; ++m)
#pragma unroll
        for (int n = 0; n < 2; ++n) { ah[m][n] = (f32x4){0.f, 0.f, 0.f, 0.f}; al[m][n] = (f32x4){0.f, 0.f, 0.f, 0.f}; }
#pragma unroll
      for (int ks = 0; ks < 4; ++ks) {
        h16x8 Ah[2], Al[2], Bh[2], Bl[2];
#pragma unroll
        for (int m = 0; m < 2; ++m) {
          const f32x4 q0 = *(const f32x4*)(qa + (size_t)m * 16 * 2048 + ks * 32), q1 = *(const f32x4*)(qa + (size_t)m * 16 * 2048 + ks * 32 + 4);
          const f32x4 k0 = *(const f32x4*)(ka + m * 16 * 128 + ks * 32), k1 = *(const f32x4*)(ka + m * 16 * 128 + ks * 32 + 4);
#pragma unroll
          for (int j = 0; j < 4; ++j) {
            Ah[m][j] = (h16)q0[j]; Al[m][j] = (h16)((q0[j] - (float)Ah[m][j]) * 2048.0f);
            Ah[m][4 + j] = (h16)q1[j]; Al[m][4 + j] = (h16)((q1[j] - (float)Ah[m][4 + j]) * 2048.0f);
            Bh[m][j] = (h16)k0[j]; Bl[m][j] = (h16)((k0[j] - (float)Bh[m][j]) * 2048.0f);
            Bh[m][4 + j] = (h16)k1[j]; Bl[m][4 + j] = (h16)((k1[j] - (float)Bh[m][4 + j]) * 2048.0f);
          }
        }
#pragma unroll
        for (int m = 0; m < 2; ++m)
#pragma unroll
          for (int n = 0; n < 2; ++n) {
            ah[m][n] = __builtin_amdgcn_mfma_f32_16x16x32_f16(Ah[m], Bh[n], ah[m][n], 0, 0, 0);
            al[m][n] = __builtin_amdgcn_mfma_f32_16x16x32_f16(Ah[m], Bl[n], al[m][n], 0, 0, 0);
            al[m][n] = __builtin_amdgcn_mfma_f32_16x16x32_f16(Al[m], Bh[n], al[m][n], 0, 0, 0);
          }
      }
#pragma unroll
      for (int m = 0; m < 2; ++m)
#pragma unroll
        for (int n = 0; n < 2; ++n) {
          const f32x4 v = ah[m][n] + al[m][n] * (1.0f / 2048.0f);
          *(h16x4*)(WSs + (size_t)(g * 128 + kb * 32 + n * 16 + fr) * 1024 + kc * 32 + m * 16 + fq * 4) = (h16x4){(h16)v[0], (h16)v[1], (h16)v[2], (h16)v[3]};
        }
    }
  }
  {
    h16* WF = (h16*)(p.ws + OFF_WF); float* SP = (float*)(p.ws + OFF_SP);
    for (int i = bid * NT + tid; i < 131072; i += nb * NT) {
      const int j = i & 7, ln = (i >> 3) & 63, fragi = i >> 9;
      const int ks = fragi & 3, mt = (fragi >> 2) & 1, gate = (fragi >> 3) & 1, dh = fragi >> 4;
      const int cout = 32 * mt + (ln & 31), cin = 16 * ks + 8 * (ln >> 5) + j;
      const float* W = gate ? p.lru_w_x : p.lru_w_a;
      WF[i] = (h16)(W[((size_t)dh * 64 + cin) * 64 + cout] * -1.4426950408889634f);
    }
    for (int i = bid * NT + tid; i < 1024; i += nb * NT) {
      SP[i] = -8.0f * 1.4426950408889634f * log1pf(expf(-p.lru_lambda[i]));
      SP[1024 + i] = p.lru_b_a[i] * -1.4426950408889634f; SP[2048 + i] = p.lru_b_x[i] * -1.4426950408889634f;
    }
  }
  {
    const int wid = tid >> 6, lane = tid & 63, gw = bid * 8 + wid, nw = nb * 8;
    for (int row = gw; row < 32768; row += nw) {
      const bool isv = row >= 16384; const int rr = row & 16383;
      const f32x4* src = (const f32x4*)((isv ? p.peer_v : p.peer_u) + (size_t)rr * 1024 + lane * 16);
      const f32x4 a = src[0], b = src[1], c = src[2], d = src[3];
      float am = 0.0f;
#pragma unroll
      for (int j = 0; j < 4; ++j) am = fmaxf(fmaxf(am, fabsf(a[j])), fmaxf(fmaxf(fabsf(b[j]), fabsf(c[j])), fabsf(d[j])));
      am = __uint_as_float(wave_max_u(__float_as_uint(am)));
      u32x4 o;
      if (isv) {
        const float sc = am > 0.0f ? 6.0f / am : 1.0f;
        unsigned w0 = 0u, w1 = 0u;
        w0 = __builtin_amdgcn_cvt_scalef32_pk_fp4_f32(w0, a[0] * sc, a[1] * sc, 1.0f, 0); w0 = __builtin_amdgcn_cvt_scalef32_pk_fp4_f32(w0, a[2] * sc, a[3] * sc, 1.0f, 1);
        w0 = __builtin_amdgcn_cvt_scalef32_pk_fp4_f32(w0, b[0] * sc, b[1] * sc, 1.0f, 2); w0 = __builtin_amdgcn_cvt_scalef32_pk_fp4_f32(w0, b[2] * sc, b[3] * sc, 1.0f, 3);
        w1 = __builtin_amdgcn_cvt_scalef32_pk_fp4_f32(w1, c[0] * sc, c[1] * sc, 1.0f, 0); w1 = __builtin_amdgcn_cvt_scalef32_pk_fp4_f32(w1, c[2] * sc, c[3] * sc, 1.0f, 1);
        w1 = __builtin_amdgcn_cvt_scalef32_pk_fp4_f32(w1, d[0] * sc, d[1] * sc, 1.0f, 2); w1 = __builtin_amdgcn_cvt_scalef32_pk_fp4_f32(w1, d[2] * sc, d[3] * sc, 1.0f, 3);
        {
          const int ci = lane >> 4, cq = (lane & 15) >> 2;
          unsigned char* vrow = (unsigned char*)(p.ws + OFF_VB) + (size_t)rr * 512 + (ci >> 1) * 256 + ((ci & 1) * 2 + (cq >> 1)) * 4 + (cq & 1) * 2;
          *(unsigned short*)(vrow + (4 * (lane & 3) + 0) * 16) = (unsigned short)(w0 & 0xffffu);
          *(unsigned short*)(vrow + (4 * (lane & 3) + 1) * 16) = (unsigned short)(w0 >> 16);
          *(unsigned short*)(vrow + (4 * (lane & 3) + 2) * 16) = (unsigned short)(w1 & 0xffffu);
          *(unsigned short*)(vrow + (4 * (lane & 3) + 3) * 16) = (unsigned short)(w1 >> 16);
        }
        if (lane == 0) ((float*)(p.ws + OFF_UB + 16777216))[rr * 2 + 1] = am * (1.0f / 6.0f);
        continue;
      } else {
        const float sc = am > 0.0f ? 127.0f / am : 1.0f;
        auto q4 = [&](const f32x4& v) -> unsigned {
          const int q0 = (int)rintf(v[0] * sc), q1 = (int)rintf(v[1] * sc), q2 = (int)rintf(v[2] * sc), q3 = (int)rintf(v[3] * sc);
          return (unsigned)(q0 & 255) | ((unsigned)(q1 & 255) << 8) | ((unsigned)(q2 & 255) << 16) | ((unsigned)(q3 & 255) << 24);
        };
        o[0] = q4(a); o[1] = q4(b); o[2] = q4(c); o[3] = q4(d);
      }
      {
        unsigned* urow = (unsigned*)(p.ws + OFF_UB + (size_t)rr * 1024 + (lane >> 4) * 256) + ((lane & 15) >> 2);
        urow[(4 * (lane & 3) + 0) * 4] = o[0]; urow[(4 * (lane & 3) + 1) * 4] = o[1]; urow[(4 * (lane & 3) + 2) * 4] = o[2]; urow[(4 * (lane & 3) + 3) * 4] = o[3];
      }
      if (lane == 0) ((float*)(p.ws + OFF_UB + 16777216))[rr * 2] = am * (1.0f / 127.0f);
    }
  }
}

DEVI void phase0b(const Params& p, char* shm, int bid, int nb) {
  const int tid = threadIdx.x, wid = tid >> 6, lane = tid & 63, gw = bid * 8 + wid, nw = nb * 8;
  const float* MOD = (const float*)(p.ws + OFF_MOD);
  h16* XS = (h16*)(p.ws + OFF_XS);
  float* RSTD1 = (float*)(p.ws + OFF_RSTD1);
  f32x4 gsv[4]; int curb = -1;
  for (int tok = gw; tok < 33792; tok += nw) {
    const int bb = tok < 32768 ? (tok >> 13) : 4;
    const float* src = tok < 32768 ? p.x + (size_t)tok * 1024 : p.ctx + (size_t)(tok - 32768) * 1024;
    if (bb != curb) {
      const float* mod = MOD + bb * 6144;
#pragma unroll
      for (int i = 0; i < 4; ++i) { const int k = i * 256 + lane * 4; gsv[i] = *(const f32x4*)(p.norm1_g + k) * (*(const f32x4*)(mod + 1024 + k) + 1.0f); }
      curb = bb;
    }
    float ss = 0;
    f32x4 xv4[4];
#pragma unroll
    for (int i = 0; i < 4; ++i) xv4[i] = *(const f32x4*)(src + i * 256 + lane * 4);
#pragma unroll
    for (int i = 0; i < 4; ++i) {
      const int k = i * 256 + lane * 4;
      const f32x4 xv = xv4[i];
      ss += (xv[0] * xv[0] + xv[1] * xv[1]) + (xv[2] * xv[2] + xv[3] * xv[3]);
      const f32x4 y = xv * gsv[i];
      h16x4 o = {(h16)y[0], (h16)y[1], (h16)y[2], (h16)y[3]};
      *(h16x4*)(XS + (size_t)tok * 1024 + k) = o;
    }
    ss = wave_sum(ss);
    if (lane == 0) RSTD1[tok] = rsqrtf(ss * (1.0f / 1024.0f) + 1e-6f);
  }
  const h16* WIN = (const h16*)(p.ws + OFF_WIN);
  const h16* WSs = (const h16*)(p.ws + OFF_WS);
  {
    h16* WSB = (h16*)(p.ws + OFF_HB);
    for (int i = bid * NT + tid; i < 2048 * 128; i += nb * NT) {
      const int n = i >> 7, k = (i & 127) * 8;
      const h16x8 w = *(const h16x8*)(WSs + (size_t)n * 1024 + k);
      const f32x4 ga = *(const f32x4*)(p.norm2_g + k), gb = *(const f32x4*)(p.norm2_g + k + 4);
#pragma unroll
      for (int b = 0; b < 4; ++b) {
        const f32x4 sa = *(const f32x4*)(MOD + b * 6144 + 4096 + k) + 1.0f, sb = *(const f32x4*)(MOD + b * 6144 + 4096 + k + 4) + 1.0f;
        h16x8 o;
#pragma unroll
        for (int j = 0; j < 4; ++j) { o[j] = (h16)((float)w[j] * ga[j] * sa[j]); o[4 + j] = (h16)((float)w[4 + j] * gb[j] * sb[j]); }
        *(h16x8*)(WSB + ((size_t)b * 2048 + n) * 1024 + k) = o;
      }
    }
  }
  float* BIAS1 = (float*)(p.ws + OFF_BIAS1);
  float* BIAS3 = (float*)(p.ws + OFF_BIAS3);
  for (int n = gw; n < 1536 + 2048; n += nw) {
    const bool is3 = n >= 1536; const int nn = is3 ? n - 1536 : n;
    const h16* wrow = (is3 ? WSs : WIN) + (size_t)nn * 1024;
    const h16x8 w0 = *(const h16x8*)(wrow + lane * 8), w1 = *(const h16x8*)(wrow + 512 + lane * 8);
    const int nv = is3 ? 4 : 5;
    for (int bb = 0; bb < nv; ++bb) {
      const float* sh = MOD + bb * 6144 + (is3 ? 3072 : 0);
      float s = 0;
#pragma unroll
      for (int j = 0; j < 8; ++j) s += (float)w0[j] * sh[lane * 8 + j] + (float)w1[j] * sh[512 + lane * 8 + j];
      s = wave_sum(s);
      if (lane == 0) { if (is3) BIAS3[bb * 2048 + nn] = s; else BIAS1[bb * 1536 + nn] = s; }
    }
  }
}

DEVI void phase1(const Params& p, char* shm, int bid, int nb) {
  const h16* XS = (const h16*)(p.ws + OFF_XS);
  const h16* WIN = (const h16*)(p.ws + OFF_WIN);
  for (int i = 0;; ++i) {
    const long L = (long)i * nb + bid; if (L >= 768) break;
    int pm, pn;
    tile_order((int)L, 128, 6, pm, pn);
    if (pn < 2) gemm_tile<1, false>(p, XS, WIN, pm, pn, shm); else gemm_tile<1, true>(p, XS, WIN, pm, pn, shm);
  }
}

typedef float f32x16 __attribute__((ext_vector_type(16)));
template <int CTRL> DEVI float dpp_old(float v, float old) {
  return __builtin_bit_cast(float, __builtin_amdgcn_update_dpp(__builtin_bit_cast(int, old), __builtin_bit_cast(int, v), CTRL, 0xf, 0xf, false));
}
template <int PAT> DEVI float swz(float v) { return __builtin_bit_cast(float, __builtin_amdgcn_ds_swizzle(__builtin_bit_cast(int, v), PAT)); }
template <int D> DEVI void scan32(float& a, float& b, int lane) {
#define LSTEP(CTRL) { const float ap = dpp_old<CTRL>(a, 1.0f), bp = dpp_old<CTRL>(b, 0.0f); b = a * bp + b; a = a * ap; }
  if (D == 0) {
    LSTEP(0x111) LSTEP(0x112) LSTEP(0x114) LSTEP(0x118)
    const float ap = __builtin_bit_cast(float, __builtin_amdgcn_update_dpp(__builtin_bit_cast(int, 1.0f), __builtin_bit_cast(int, a), 0x142, 0xa, 0xf, false));
    const float bp = __builtin_bit_cast(float, __builtin_amdgcn_update_dpp(__builtin_bit_cast(int, 0.0f), __builtin_bit_cast(int, b), 0x142, 0xa, 0xf, false));
    b = a * bp + b; a = a * ap;
  } else {
    LSTEP(0x101) LSTEP(0x102) LSTEP(0x104) LSTEP(0x108)
    float ap = swz<0x200>(a), bp = swz<0x200>(b);
    if (lane & 16) { ap = 1.0f; bp = 0.0f; }
    b = a * bp + b; a = a * ap;
  }
#undef LSTEP
}
template <int D> DEVI void scan_section(f32x16 (&aa)[2], f32x16 (&ax)[2], int lane) {
#define SSTEP(CTRL, RMASK) { _Pragma("unroll") for (int nt = 0; nt < 2; ++nt) { _Pragma("unroll") for (int rb = 0; rb < 16; rb += 8) { \
    float a0_ = aa[nt][rb], a1_ = aa[nt][rb + 1], a2_ = aa[nt][rb + 2], a3_ = aa[nt][rb + 3], a4_ = aa[nt][rb + 4], a5_ = aa[nt][rb + 5], a6_ = aa[nt][rb + 6], a7_ = aa[nt][rb + 7]; \
    float b0_ = ax[nt][rb], b1_ = ax[nt][rb + 1], b2_ = ax[nt][rb + 2], b3_ = ax[nt][rb + 3], b4_ = ax[nt][rb + 4], b5_ = ax[nt][rb + 5], b6_ = ax[nt][rb + 6], b7_ = ax[nt][rb + 7]; \
    asm volatile("s_nop 1\n\t" \
      "v_fmac_f32_dpp %0, %0, %8 " CTRL " row_mask:" RMASK " bank_mask:0xf\n\tv_mul_f32_dpp %8, %8, %8 " CTRL " row_mask:" RMASK " bank_mask:0xf\n\t" \
      "v_fmac_f32_dpp %1, %1, %9 " CTRL " row_mask:" RMASK " bank_mask:0xf\n\tv_mul_f32_dpp %9, %9, %9 " CTRL " row_mask:" RMASK " bank_mask:0xf\n\t" \
      "v_fmac_f32_dpp %2, %2, %10 " CTRL " row_mask:" RMASK " bank_mask:0xf\n\tv_mul_f32_dpp %10, %10, %10 " CTRL " row_mask:" RMASK " bank_mask:0xf\n\t" \
      "v_fmac_f32_dpp %3, %3, %11 " CTRL " row_mask:" RMASK " bank_mask:0xf\n\tv_mul_f32_dpp %11, %11, %11 " CTRL " row_mask:" RMASK " bank_mask:0xf\n\t" \
      "v_fmac_f32_dpp %4, %4, %12 " CTRL " row_mask:" RMASK " bank_mask:0xf\n\tv_mul_f32_dpp %12, %12, %12 " CTRL " row_mask:" RMASK " bank_mask:0xf\n\t" \
      "v_fmac_f32_dpp %5, %5, %13 " CTRL " row_mask:" RMASK " bank_mask:0xf\n\tv_mul_f32_dpp %13, %13, %13 " CTRL " row_mask:" RMASK " bank_mask:0xf\n\t" \
      "v_fmac_f32_dpp %6, %6, %14 " CTRL " row_mask:" RMASK " bank_mask:0xf\n\tv_mul_f32_dpp %14, %14, %14 " CTRL " row_mask:" RMASK " bank_mask:0xf\n\t" \
      "v_fmac_f32_dpp %7, %7, %15 " CTRL " row_mask:" RMASK " bank_mask:0xf\n\tv_mul_f32_dpp %15, %15, %15 " CTRL " row_mask:" RMASK " bank_mask:0xf" \
      : "+v"(b0_), "+v"(b1_), "+v"(b2_), "+v"(b3_), "+v"(b4_), "+v"(b5_), "+v"(b6_), "+v"(b7_), "+v"(a0_), "+v"(a1_), "+v"(a2_), "+v"(a3_), "+v"(a4_), "+v"(a5_), "+v"(a6_), "+v"(a7_)); \
    aa[nt][rb] = a0_; aa[nt][rb + 1] = a1_; aa[nt][rb + 2] = a2_; aa[nt][rb + 3] = a3_; aa[nt][rb + 4] = a4_; aa[nt][rb + 5] = a5_; aa[nt][rb + 6] = a6_; aa[nt][rb + 7] = a7_; \
    ax[nt][rb] = b0_; ax[nt][rb + 1] = b1_; ax[nt][rb + 2] = b2_; ax[nt][rb + 3] = b3_; ax[nt][rb + 4] = b4_; ax[nt][rb + 5] = b5_; ax[nt][rb + 6] = b6_; ax[nt][rb + 7] = b7_; } } }
  if (D == 0) {
    SSTEP("row_shr:1", "0xf") SSTEP("row_shr:2", "0xf") SSTEP("row_shr:4", "0xf") SSTEP("row_shr:8", "0xf") SSTEP("row_bcast:15", "0xa")
  } else {
    SSTEP("row_shl:1", "0xf") SSTEP("row_shl:2", "0xf") SSTEP("row_shl:4", "0xf") SSTEP("row_shl:8", "0xf")
#pragma unroll
    for (int nt = 0; nt < 2; ++nt)
#pragma unroll
      for (int r = 0; r < 16; ++r) {
        float ap = swz<0x200>(aa[nt][r]), bp = swz<0x200>(ax[nt][r]);
        if (lane & 16) { ap = 1.0f; bp = 0.0f; }
        ax[nt][r] = aa[nt][r] * bp + ax[nt][r]; aa[nt][r] = aa[nt][r] * ap;
      }
  }
#undef SSTEP
}
constexpr int LRU_WAVE_LDS = 18432, LRU_SSQ_OFF = 8 * LRU_WAVE_LDS;
template <int MODE>
DEVI void lru_unit(const Params& p, char* shm, int q) {
  int tid_o = threadIdx.x; asm volatile("" : "+v"(tid_o));
  const int tid = tid_o, wid = __builtin_amdgcn_readfirstlane(tid >> 6), lane = tid & 63, ch = wid * 64 + lane, half = lane >> 5, ln = lane & 31;
  const h16* UX = (const h16*)(p.ws + OFF_UX);
  h16* xh = (h16*)(shm + wid * LRU_WAVE_LDS);
  h16* hx = xh + 4608;
  float* ssq_l = (float*)(shm + LRU_SSQ_OFF);
  int tok0, lo, hi, b, jj;
  if (q < 512) { tok0 = q * 64; lo = tok0; hi = tok0 + 64; b = q >> 7; jj = 4 + (q & 127); }
  else { const int cq = q - 512; b = cq >> 2; lo = 32768 + b * 256; hi = lo + 256; tok0 = lo + (cq & 3) * 64; jj = cq & 3; }
  {
    const float cw0 = p.conv_w[ch], cw1 = p.conv_w[512 + ch], cw2 = p.conv_w[1024 + ch], cw3 = p.conv_w[1536 + ch], cb = p.conv_b[ch];
    h16* raw = hx;
    {
      u32x4 rv[9];
#pragma unroll
      for (int j = 0; j < 9; ++j) {
        const int tk = tok0 - 2 + 8 * j + (lane >> 3), tkc = tk < lo ? lo : (tk >= hi ? hi - 1 : tk);
        rv[j] = *(const u32x4*)(UX + (size_t)tkc * 512 + wid * 64 + (lane & 7) * 8);
      }
      __builtin_amdgcn_sched_barrier(0);
#pragma unroll
      for (int j = 0; j < 9; ++j) {
        const int r = 8 * j + (lane >> 3), tk = tok0 - 2 + r;
        const u32x4 z = {0u, 0u, 0u, 0u};
        const u32x4 v = (tk >= lo && tk < hi) ? rv[j] : z;
        if (r < 67) *(u32x4*)(raw + r * 64 + (lane & 7) * 8) = v;
      }
    }
    asm volatile("s_waitcnt lgkmcnt(0)" ::: "memory");
    float xv[67];
#pragma unroll
    for (int i = 0; i < 67; ++i) xv[i] = (float)raw[i * 64 + lane];
    asm volatile("" ::: "memory");
#pragma unroll
    for (int t = 0; t < 64; ++t) xh[t * 72 + lane] = (h16)(cb + cw0 * xv[t] + cw1 * xv[t + 1] + cw2 * xv[t + 2] + cw3 * xv[t + 3]);
  }
  h16x8 Bf[2][4];
#pragma unroll
  for (int nt = 0; nt < 2; ++nt)
#pragma unroll
    for (int ks = 0; ks < 4; ++ks) Bf[nt][ks] = *(const h16x8*)(xh + (32 * nt + ln) * 72 + 16 * ks + 8 * half);
  const h16x8* WF = (const h16x8*)(p.ws + OFF_WF);
  const float* SP = (const float*)(p.ws + OFF_SP);
  const h16* GXG = (const h16*)(p.ws + OFF_GXG);
  const float* CARRY = (const float*)(p.ws + OFF_CARRY);
  f32x2* AGG = (f32x2*)(p.ws + OFF_AGG);
  float ssq[2] = {0.0f, 0.0f};
  h16x8 WA[4], WX[4];
  {
    const h16x8* wfa = WF + ((size_t)(((1 * 8 + wid) * 2 + 0) * 8) * 64 + lane);
    const h16x8* wfx = WF + ((size_t)(((1 * 8 + wid) * 2 + 1) * 8) * 64 + lane);
#pragma unroll
    for (int ks = 0; ks < 4; ++ks) { WA[ks] = wfa[ks * 64]; WX[ks] = wfx[ks * 64]; }
  }
#pragma unroll 1
  for (int mt = 0; mt < 2; ++mt) {
#pragma unroll
    for (int dd = 0; dd < 2; ++dd) {
      const int d = 1 - dd;
      int lane_o = threadIdx.x & 63; asm volatile("" : "+v"(lane_o));
      const int lane = lane_o, half = lane >> 5, ln = lane & 31;
      f32x16 aa[2], ax[2];
      f32x4 sp4v[4];
#pragma unroll
      for (int g = 0; g < 4; ++g) {
        const int c0 = 32 * mt + 8 * g + 4 * half;
        const f32x4 ba4 = *(const f32x4*)(SP + 1024 + d * 512 + wid * 64 + c0), bx4 = *(const f32x4*)(SP + 2048 + d * 512 + wid * 64 + c0);
        sp4v[g] = *(const f32x4*)(SP + d * 512 + wid * 64 + c0);
#pragma unroll
        for (int nt = 0; nt < 2; ++nt)
#pragma unroll
          for (int j = 0; j < 4; ++j) { aa[nt][4 * g + j] = ba4[j]; ax[nt][4 * g + j] = bx4[j]; }
      }
#pragma unroll
      for (int ks = 0; ks < 4; ++ks) {
#pragma unroll
        for (int nt = 0; nt < 2; ++nt) {
          aa[nt] = __builtin_amdgcn_mfma_f32_32x32x16_f16(WA[ks], Bf[nt][ks], aa[nt], 0, 0, 0);
          ax[nt] = __builtin_amdgcn_mfma_f32_32x32x16_f16(WX[ks], Bf[nt][ks], ax[nt], 0, 0, 0);
        }
      }
      {
        const int dn = dd == 0 ? 0 : 1, mtn = dd == 0 ? mt : (mt < 1 ? mt + 1 : 1);
        const h16x8* wfa = WF + ((size_t)(((dn * 8 + wid) * 2 + 0) * 8 + mtn * 4) * 64 + lane);
        const h16x8* wfx = WF + ((size_t)(((dn * 8 + wid) * 2 + 1) * 8 + mtn * 4) * 64 + lane);
#pragma unroll
        for (int ks = 0; ks < 4; ++ks) { WA[ks] = wfa[ks * 64]; WX[ks] = wfx[ks * 64]; }
      }
#pragma unroll
      for (int g = 0; g < 4; ++g) {
        const int c0 = 32 * mt + 8 * g + 4 * half;
        const f32x4 sp4 = sp4v[g];
#pragma unroll
        for (int nt = 0; nt < 2; ++nt) {
          const h16x4 xc4 = *(const h16x4*)(xh + (32 * nt + ln) * 72 + c0);
#pragma unroll
          for (int j = 0; j < 4; ++j) {
            const int r = 4 * g + j;
            const float rg = __builtin_amdgcn_rcpf(1.0f + __builtin_amdgcn_exp2f(aa[nt][r]));
            const float ig = __builtin_amdgcn_rcpf(1.0f + __builtin_amdgcn_exp2f(ax[nt][r]));
            const float a = __builtin_amdgcn_exp2f(rg * sp4[j]);
            const float em = __builtin_fmaf(-a, a, 1.0f);
            aa[nt][r] = a; ax[nt][r] = __builtin_amdgcn_sqrtf(em) * ig * (float)xc4[j];
          }
        }
      }
      if (d) scan_section<1>(aa, ax, lane); else scan_section<0>(aa, ax, lane);
#pragma unroll
      for (int r = 0; r < 16; ++r) {
        if (d == 0) { const float ta = swz<0x3E0>(aa[0][r]), tb = swz<0x3E0>(ax[0][r]); ax[1][r] = aa[1][r] * tb + ax[1][r]; aa[1][r] = aa[1][r] * ta; }
        else        { const float ta = swz<0x000>(aa[1][r]), tb = swz<0x000>(ax[1][r]); ax[0][r] = aa[0][r] * tb + ax[0][r]; aa[0][r] = aa[0][r] * ta; }
      }
      if (MODE == 0) {
        if (ln == (d ? 0 : 31)) {
#pragma unroll
          for (int r = 0; r < 16; ++r) {
            const int c = 32 * mt + (r & 3) + 8 * (r >> 2) + 4 * half;
            AGG[((size_t)(b * 132 + jj) * 2 + d) * 512 + wid * 64 + c] = d ? (f32x2){aa[0][r], ax[0][r]} : (f32x2){aa[1][r], ax[1][r]};
          }
        }
      } else {
#pragma unroll
        for (int g = 0; g < 4; ++g) {
          const int c0 = 32 * mt + 8 * g + 4 * half;
          const f32x4 h0 = *(const f32x4*)(CARRY + ((size_t)(b * 128 + (q & 127)) * 2 + d) * 512 + wid * 64 + c0);
#pragma unroll
          for (int nt = 0; nt < 2; ++nt) {
            h16* hp = hx + (32 * nt + ln) * 72 + c0;
            f32x4 hv;
#pragma unroll
            for (int j = 0; j < 4; ++j) hv[j] = aa[nt][4 * g + j] * h0[j] + ax[nt][4 * g + j];
            if (d == 1) {
              *(h16x4*)hp = (h16x4){(h16)hv[0], (h16)hv[1], (h16)hv[2], (h16)hv[3]};
            } else {
              const h16x4 hb4 = *(const h16x4*)hp;
              const h16x4 gxh = *(const h16x4*)(GXG + (size_t)(tok0 + 32 * nt + ln) * 512 + wid * 64 + c0);
              const f32x4 gx4 = {(float)gxh[0], (float)gxh[1], (float)gxh[2], (float)gxh[3]};
              h16x4 o;
#pragma unroll
              for (int j = 0; j < 4; ++j) { const float rx = (hv[j] + (float)hb4[j]) * gx4[j]; ssq[nt] += rx * rx; o[j] = (h16)rx; }
              *(h16x4*)hp = o;
            }
          }
        }
      }
      __builtin_amdgcn_sched_barrier(0);
    }
  }
  if (MODE == 1) {
    int lane_o = threadIdx.x & 63; asm volatile("" : "+v"(lane_o));
    const int lane = lane_o, half = lane >> 5, ln = lane & 31;
#pragma unroll
    for (int nt = 0; nt < 2; ++nt) {
      const float s = ssq[nt] + __shfl_xor(ssq[nt], 32);
      if (half == 0) ssq_l[wid * 64 + 32 * nt + ln] = s;
    }
    __syncthreads();
    h16* A2 = (h16*)(p.ws + OFF_A2);
    const int cc = (lane & 7) * 8;
    const f32x4 ga = *(const f32x4*)(p.lru_out_g + wid * 64 + cc), gb = *(const f32x4*)(p.lru_out_g + wid * 64 + cc + 4);
#pragma unroll 2
    for (int i = 0; i < 8; ++i) {
      const int t = (lane >> 3) + 8 * i;
      float tot = 0;
#pragma unroll
      for (int w = 0; w < 8; ++w) tot += ssq_l[w * 64 + t];
      const float rstd = rsqrtf(tot * (1.0f / 512.0f) + 1e-6f);
      const h16x8 rv = *(const h16x8*)(hx + t * 72 + cc);
      h16x8 o;
#pragma unroll
      for (int j = 0; j < 4; ++j) { o[j] = (h16)((float)rv[j] * rstd * ga[j]); o[4 + j] = (h16)((float)rv[4 + j] * rstd * gb[j]); }
      *(h16x8*)(A2 + (size_t)(tok0 + t) * 1024 + 512 + wid * 64 + cc) = o;
    }
  }
}

DEVI void phase1b(const Params& p, char* shm, int bid, int nb);

DEVI int fpad(int i) { return i + (i >> 7); }
DEVI void phase2(const Params& p, char* shm, int bid, int nb) {
  const int tid = threadIdx.x, wid = tid >> 6, lane = tid & 63;
  if (bid < 32) {
    const int chain = bid * 2 + (wid >> 2), qtr = wid & 3;
    const int b = chain >> 4, d = (chain >> 3) & 1, ch = (chain & 7) * 64 + lane;
    const f32x2* AGG = (const f32x2*)(p.ws + OFF_AGG);
    float* CARRY = (float*)(p.ws + OFF_CARRY);
    f32x2* xq = (f32x2*)shm;
    f32x2 ab[33];
#pragma unroll
    for (int i = 0; i < 33; ++i) {
      const int s = qtr * 33 + i;
      const int j = d == 0 ? s : (s < 4 ? 3 - s : 4 + (131 - s));
      ab[i] = AGG[((size_t)(b * 132 + j) * 2 + d) * 512 + ch];
    }
    float A = 1.0f, B = 0.0f;
#pragma unroll
    for (int i = 0; i < 33; ++i) { B = ab[i][0] * B + ab[i][1]; A = ab[i][0] * A; }
    xq[wid * 64 + lane] = (f32x2){A, B};
    __syncthreads();
    float h = 0.0f;
    for (int pq = 0; pq < qtr; ++pq) { const f32x2 m = xq[((wid & 4) + pq) * 64 + lane]; h = m[0] * h + m[1]; }
#pragma unroll
    for (int i = 0; i < 33; ++i) {
      const int s = qtr * 33 + i;
      const int j = d == 0 ? s : (s < 4 ? 3 - s : 4 + (131 - s));
      if (j >= 4) CARRY[((size_t)(b * 128 + (j - 4)) * 2 + d) * 512 + ch] = h;
      h = ab[i][0] * h + ab[i][1];
    }
  }
}

DEVI void fft_units(const Params& p, char* shm, int u_lo, int u_hi, int u_step) {
  const int tid = threadIdx.x;
  f32x2* dt = (f32x2*)shm;
  f32x2* tw = (f32x2*)(shm + 68096);
  __syncthreads();
  {
    const f32x2* TW = (const f32x2*)(p.ws + OFF_TW);
    for (int j = tid; j < 4096; j += NT) tw[fpad(j)] = TW[j];
  }
  h16* GT = (h16*)(p.ws + OFF_GT);
  const float nrm = 0.0013810679320049757f;
  auto dpad = [](int i) -> int { return i + 18 * (i >> 9) + ((i >> 5) & 15); };
  auto twid = [&](int j) -> f32x2 {
    const f32x2 w = tw[fpad(j & 4095)];
    return (j & 4096) ? (f32x2){-w[0], -w[1]} : w;
  };
  for (int u = u_lo; u < u_hi; u += u_step) {
    const int b = u >> 8, h = (u >> 5) & 7, m = u & 31;
    const int s0 = m, s1 = m == 0 ? 32 : 64 - m;
    h16* g0 = GT + (size_t)(b * 512 + h * 64 + s0) * 8192;
    h16* g1 = GT + (size_t)(b * 512 + h * 64 + s1) * 8192;
    const float sg = m == 0 ? 1.0f : -1.0f;
    __syncthreads();
#pragma unroll 4
    for (int t = 2 * tid; t < 8192; t += 2 * NT) {
      const h16x2 a0 = *(const h16x2*)(g0 + t), a1 = *(const h16x2*)(g1 + t);
      dt[dpad(t)] = (f32x2){(float)a0[0], sg * (float)a1[0]}; dt[dpad(t + 1)] = (f32x2){(float)a0[1], sg * (float)a1[1]};
    }
    __syncthreads();
#pragma unroll 1
    for (int pass = 0; pass < 3; ++pass) {
      const int lgS = pass == 0 ? 9 : (pass == 1 ? 5 : 1);
      const int S = 1 << lgS;
      const int r = tid & (S - 1), base = ((tid >> lgS) << (lgS + 4)) + r;
      f32x2 x[16];
#pragma unroll
      for (int j = 0; j < 16; ++j) x[j] = dt[dpad(base + (j << lgS))];
      const float c1 = 0.9238795325112867f, s1_ = 0.3826834323650898f, c2 = 0.7071067811865476f;
#define CMULC(v, wr_, wi_) { const float tr = v[0] * (wr_) - v[1] * (wi_), ti = v[0] * (wi_) + v[1] * (wr_); v[0] = tr; v[1] = ti; }
#pragma unroll
      for (int j = 0; j < 8; ++j) { const f32x2 a = x[j], bq = x[j + 8]; x[j] = a + bq; x[j + 8] = a - bq; }
      CMULC(x[9], c1, -s1_) CMULC(x[10], c2, -c2) CMULC(x[11], s1_, -c1) { const f32x2 v = x[12]; x[12] = (f32x2){v[1], -v[0]}; }
      CMULC(x[13], -s1_, -c1) CMULC(x[14], -c2, -c2) CMULC(x[15], -c1, -s1_)
#pragma unroll
      for (int g = 0; g < 16; g += 8)
#pragma unroll
        for (int j = 0; j < 4; ++j) { const f32x2 a = x[g + j], bq = x[g + j + 4]; x[g + j] = a + bq; x[g + j + 4] = a - bq; }
#pragma unroll
      for (int g = 0; g < 16; g += 8) { CMULC(x[g + 5], c2, -c2) { const f32x2 v = x[g + 6]; x[g + 6] = (f32x2){v[1], -v[0]}; } CMULC(x[g + 7], -c2, -c2) }
#pragma unroll
      for (int g = 0; g < 16; g += 4)
#pragma unroll
        for (int j = 0; j < 2; ++j) { const f32x2 a = x[g + j], bq = x[g + j + 2]; x[g + j] = a + bq; x[g + j + 2] = a - bq; }
#pragma unroll
      for (int g = 0; g < 16; g += 4) { const f32x2 v = x[g + 3]; x[g + 3] = (f32x2){v[1], -v[0]}; }
#pragma unroll
      for (int g = 0; g < 16; g += 2) { const f32x2 a = x[g], bq = x[g + 1]; x[g] = a + bq; x[g + 1] = a - bq; }
      const int tsh = 13 - (lgS + 4);
#pragma unroll
      for (int q = 0; q < 16; ++q) {
        const int pos = ((q & 1) << 3) | ((q & 2) << 1) | ((q & 4) >> 1) | ((q & 8) >> 3);
        f32x2 v = x[pos];
        if (q) { const f32x2 w = twid((r * q) << tsh); CMULC(v, w[0], w[1]) }
        dt[dpad(base + (q << lgS))] = v;
      }
#undef CMULC
      __syncthreads();
    }
    auto rdW = [&](int k) -> f32x2 {
      const int pp = ((k & 15) << 9) + (((k >> 4) & 15) << 5) + (((k >> 8) & 15) << 1);
      const f32x2 a = dt[dpad(pp)], bq = dt[dpad(pp + 1)];
      return (k & 4096) ? a - bq : a + bq;
    };
#pragma unroll 2
    for (int k = 2 * tid; k < 8192; k += 2 * NT) {
      float y0[2], y1[2];
#pragma unroll
      for (int u2 = 0; u2 < 2; ++u2) {
        const f32x2 w1 = rdW(k + u2), w2 = rdW((8192 - (k + u2)) & 8191);
        if (m == 0) { y0[u2] = 0.5f * (w1[0] + w2[0]); y1[u2] = 0.5f * (w1[1] + w2[1]); }
        else { y0[u2] = w1[0]; y1[u2] = w2[0]; }
      }
      *(h16x2*)(g0 + k) = (h16x2){(h16)(y0[0] * nrm), (h16)(y0[1] * nrm)};
      *(h16x2*)(g1 + k) = (h16x2){(h16)(y1[0] * nrm), (h16)(y1[1] * nrm)};
    }
  }
}

DEVI void phase1b(const Params& p, char* shm, int bid, int nb) {
  const int tid = threadIdx.x;
  unsigned* flg = (unsigned*)(p.ws + OFF_BAR);
  for (int t = bid; t < 8; t += nb) {
    gemm_tile<1, true>(p, (const h16*)(p.ws + OFF_XS), (const h16*)(p.ws + OFF_WIN), 128 + (t >> 1), 2 + (t & 1), shm);
    asm volatile("s_waitcnt vmcnt(0)" ::: "memory");
    __syncthreads();
    if (tid == 0) {
      __builtin_amdgcn_fence(__ATOMIC_RELEASE, "agent");
      asm volatile("s_waitcnt vmcnt(0)" ::: "memory");
      __hip_atomic_fetch_add(flg + t, 1u, __ATOMIC_RELAXED, __HIP_MEMORY_SCOPE_AGENT);
    }
  }
  for (int q = bid; q < 528; q += nb) {
    __syncthreads();
    if (q >= 512) {
      const int b = (q - 512) >> 2;
      if (tid == 0) {
        unsigned sp = 0;
        while ((__hip_atomic_load(flg + 2 * b, __ATOMIC_RELAXED, __HIP_MEMORY_SCOPE_AGENT) == 0u ||
                __hip_atomic_load(flg + 2 * b + 1, __ATOMIC_RELAXED, __HIP_MEMORY_SCOPE_AGENT) == 0u) && ++sp < (1u << 20)) __builtin_amdgcn_s_sleep(4);
        __builtin_amdgcn_fence(__ATOMIC_ACQUIRE, "agent");
        asm volatile("s_waitcnt vmcnt(0)" ::: "memory");
      }
      __syncthreads();
    }
    lru_unit<0>(p, shm, q);
  }
  if (nb == 256) {
    int lo, cnt;
    if (bid < 8) { lo = bid; cnt = 1; } else if (bid < 16) { lo = 8 + (bid - 8) * 3; cnt = 3; } else if (bid < 48) { lo = 32 + (bid - 16) * 5; cnt = 5; } else { lo = 192 + (bid - 48) * 4; cnt = 4; }
    fft_units(p, shm, lo, lo + cnt, 1);
  } else fft_units(p, shm, bid, 1024, nb);
}

DEVI void phase3a(const Params& p, char* shm, int bid, int nb) {
  const int tid = threadIdx.x, wid = tid >> 6, lane = tid & 63;
  for (int q = bid; q < 512; q += nb) {
    __syncthreads();
    lru_unit<1>(p, shm, q);
    __syncthreads();
    int tid_o = threadIdx.x; asm volatile("" : "+v"(tid_o));
    const int wid = __builtin_amdgcn_readfirstlane(tid_o >> 6), lane = tid_o & 63;
    const int b = q >> 7, t0 = (q & 127) * 64, tok0 = q * 64;
    const h16* GT = (const h16*)(p.ws + OFF_GT);
    float* yl = (float*)shm + wid * 4160;
    float* ssq_l = (float*)shm + 8 * 4160;
    float ss = 0;
#pragma unroll 32
    for (int m = 0; m < 64; ++m) {
      const float y = (float)GT[(size_t)(b * 512 + wid * 64 + m) * 8192 + t0 + lane];
      yl[m * 65 + lane] = y; ss += y * y;
    }
    ssq_l[wid * 64 + lane] = ss;
    __syncthreads();
    h16* A2 = (h16*)(p.ws + OFF_A2);
    const int mc = (lane & 7) * 8;
    float gg[8];
#pragma unroll
    for (int jj = 0; jj < 8; ++jj) gg[jj] = p.fourier_out_g[wid * 64 + mc + jj];
    for (int i = 0; i < 8; ++i) {
      const int t = (lane >> 3) + 8 * i;
      float tot = 0;
#pragma unroll
      for (int w = 0; w < 8; ++w) tot += ssq_l[w * 64 + t];
      const float rstd = rsqrtf(tot * (1.0f / 512.0f) + 1e-6f);
      h16x8 o;
#pragma unroll
      for (int jj = 0; jj < 8; ++jj) o[jj] = (h16)(yl[(mc + jj) * 65 + t] * rstd * gg[jj]);
      *(h16x8*)(A2 + (size_t)(tok0 + t) * 1024 + wid * 64 + mc) = o;
    }
  }
}

DEVI void phase3b(const Params& p, char* shm, int bid, int nb) {
  const h16* A2 = (const h16*)(p.ws + OFF_A2);
  const h16* WOUT = (const h16*)(p.ws + OFF_WOUT);
  for (int i = 0;; ++i) {
    const long L = (long)i * nb + bid; if (L >= 512) break;
    int pm, pn; tile_order((int)L, 128, 4, pm, pn);
    gemm_tile<2, true>(p, A2, WOUT, pm, pn, shm);
  }
}
DEVI void phase3c(const Params& p, char* shm, int bid, int nb) {
  const h16* X1 = (const h16*)(p.ws + OFF_GXG);
  const h16* WSB = (const h16*)(p.ws + OFF_HB);
  for (int i = 0;; ++i) {
    const long L = (long)i * nb + bid; if (L >= 1024) break;
    int pm, pn; tile_order((int)L, 128, 8, pm, pn);
    gemm_tile<3, false>(p, X1, WSB + (size_t)(pm >> 5) * 2048 * 1024, pm, pn, shm);
  }
}

#define XB_TMO      128
#define XB_XCNT(j)  (256  + 64 * (j))
#define XB_XSUB(j)  (1280 + 64 * (j))
#define XB_XGEN(j)  (2304 + 64 * (j))
#define XB_TOP      3328
#define XB_TOPGEN   3392
#define XCD_BAR_WORDS 3456
#define XB_SPIN_CAP (1u << 18)
DEVI unsigned xb_ld(unsigned* p)              { return __hip_atomic_load(p, __ATOMIC_RELAXED, __HIP_MEMORY_SCOPE_AGENT); }
DEVI unsigned xb_add(unsigned* p, unsigned v) { return __hip_atomic_fetch_add(p, v, __ATOMIC_RELAXED, __HIP_MEMORY_SCOPE_AGENT); }
DEVI unsigned xb_xcc_id() { return (unsigned)__builtin_amdgcn_s_getreg((3 << 11) | 20) & 0xFu; }
#define XB_SPIN(cond, bar) do { unsigned _sp = 0; while (cond) { __builtin_amdgcn_s_sleep(1); \
    if ((++_sp & 255u) == 0u) { if (xb_ld(&(bar)[XB_TMO])) break; if (_sp > XB_SPIN_CAP) { atomicAdd(&(bar)[XB_TMO], 1u); break; } } } } while (0)
struct XcdBarrier { unsigned* bar; unsigned x; volatile LAS unsigned* st; };
DEVI XcdBarrier xcd_barrier_post(unsigned* bar, volatile LAS unsigned* st) {
  XcdBarrier b; b.bar = bar; b.x = xb_xcc_id(); b.st = st;
  if (threadIdx.x == 0) (void)xb_add(&bar[XB_XCNT(b.x)], 1u);
  return b;
}
DEVI void xcd_barrier_complete(unsigned* bar, unsigned x, unsigned& nloc, unsigned& nx) {
  const unsigned G = gridDim.x * gridDim.y * gridDim.z;
  unsigned sum, cnt, mine, sp = 0u;
  for (;;) {
    sum = 0u; cnt = 0u; mine = 0u;
#pragma unroll
    for (unsigned j = 0; j < 16; ++j) { const unsigned c = xb_ld(&bar[XB_XCNT(j)]); sum += c; cnt += (c > 0u) ? 1u : 0u; mine = (j == x) ? c : mine; }
    if (sum == G) break;
    __builtin_amdgcn_s_sleep(1);
    if ((++sp & 255u) == 0u) { if (xb_ld(&bar[XB_TMO])) break; if (sp > XB_SPIN_CAP) { atomicAdd(&bar[XB_TMO], 1u); break; } }
  }
  nloc = mine > 0u ? mine : 1u; nx = cnt > 0u ? cnt : 1u;
}
DEVI void xcd_barrier(const XcdBarrier& b) {
  asm volatile("s_waitcnt vmcnt(0)" ::: "memory");
  __syncthreads();
  if (threadIdx.x == 0) {
    unsigned* bar = b.bar;
    __builtin_amdgcn_s_waitcnt(0);
    unsigned nloc = b.st[0], nx = b.st[1];
    if (nloc == 0u) { xcd_barrier_complete(bar, b.x, nloc, nx); b.st[0] = nloc; b.st[1] = nx; }
    const unsigned old = xb_add(&bar[XB_XSUB(b.x)], 1u);
    const unsigned gen = old / nloc;
    if (old + 1u == (gen + 1u) * nloc) {
      __builtin_amdgcn_fence(__ATOMIC_RELEASE, "agent");
      asm volatile("s_waitcnt vmcnt(0)" ::: "memory");
      const unsigned og = xb_add(&bar[XB_TOP], 1u);
      const unsigned tg = og / nx;
      if (og + 1u == (tg + 1u) * nx) xb_add(&bar[XB_TOPGEN], 1u);
      else XB_SPIN(xb_ld(&bar[XB_TOPGEN]) == tg, bar);
      __builtin_amdgcn_fence(__ATOMIC_ACQUIRE, "agent");
      xb_add(&bar[XB_XGEN(b.x)], 1u);
      asm volatile("s_waitcnt vmcnt(0)" ::: "memory");
    } else {
      XB_SPIN(xb_ld(&bar[XB_XGEN(b.x)]) == gen, bar);
      __builtin_amdgcn_fence(__ATOMIC_ACQUIRE, "agent");
      asm volatile("s_waitcnt vmcnt(0)" ::: "memory");
    }
  }
  __syncthreads();
}

template <int XM> DEVI unsigned swz_xor(unsigned v) { return (unsigned)__builtin_amdgcn_ds_swizzle((int)v, 0x1F | (XM << 10)); }
template <int K, int J> DEVI void bitonic_step(unsigned (&x)[8], int lane) {
  if constexpr (J < 8) {
#pragma unroll
    for (int r = 0; r < 8; ++r) if ((r & J) == 0) {
      const unsigned a = x[r], b = x[r | J], mn = a < b ? a : b, mx = a < b ? b : a;
      if constexpr (K < 8) { const bool asc = (r & K) == 0; x[r] = asc ? mn : mx; x[r | J] = asc ? mx : mn; }
      else { const bool asc = K >= 512 ? true : ((lane & (K >> 3)) == 0); x[r] = asc ? mn : mx; x[r | J] = asc ? mx : mn; }
    }
  } else {
    constexpr int XL = J >> 3;
    const bool asc = K >= 512 ? true : ((lane & (K >> 3)) == 0);
    const bool lower = (lane & XL) == 0;
    const bool take_min = (asc == lower);
#pragma unroll
    for (int r = 0; r < 8; ++r) {
      unsigned o;
      if constexpr (XL < 32) o = swz_xor<XL>(x[r]); else o = (unsigned)__shfl_xor((int)x[r], 32);
      const unsigned mn = x[r] < o ? x[r] : o, mx = x[r] < o ? o : x[r];
      x[r] = take_min ? mn : mx;
    }
  }
}
template <int K, int J> DEVI void bitonic_merge(unsigned (&x)[8], int lane) {
  bitonic_step<K, J>(x, lane);
  if constexpr (J > 1) bitonic_merge<K, J / 2>(x, lane);
}
template <int K> DEVI void bitonic_sort(unsigned (&x)[8], int lane) {
  if constexpr (K > 2) bitonic_sort<K / 2>(x, lane);
  bitonic_merge<K, K / 2>(x, lane);
}

DEVI void phase3d(const Params& p, char* shm, int bid, int nb, float* const outp) {
  const int tid = threadIdx.x, wid = tid >> 6, lane = tid & 63, grp = lane >> 4, q16 = lane & 15;
  const float* MOD = (const float*)(p.ws + OFF_MOD);
  const float* SSQ2 = (const float*)(p.ws + OFF_SSQ2);
  const unsigned* TOPK = (const unsigned*)(p.ws + OFF_UX);
  const unsigned char* UB8 = (const unsigned char*)(p.ws + OFF_UB);
  const unsigned char* VB8 = (const unsigned char*)(p.ws + OFF_VB);
  const f32x2* SUV = (const f32x2*)(p.ws + OFF_UB + 16777216);
  const h16* X1 = (const h16*)(p.ws + OFF_GXG);
  char* wbase = shm + wid * 7168;
  unsigned* kl = (unsigned*)wbase; float* gl = (float*)(wbase + 2048); float* sl = (float*)(wbase + 4096);
  float* GSl = (float*)(shm + 57344); float* SHl = GSl + 1024; float* G2l = GSl + 2048; float* FNl = GSl + 3072;
  for (int i = tid; i < 1024; i += NT) FNl[i] = p.final_norm_g[i];
  char* tpb = shm + 73728 + wid * 4096;
  if (bid * 8 + wid < 8192) {
    const u32x4* tsrc = (const u32x4*)(TOPK + (size_t)(bid * 8 + wid) * 4 * 256) + lane;
    u32x4 tv[4];
#pragma unroll
    for (int i = 0; i < 4; ++i) tv[i] = tsrc[i * 64];
#pragma unroll
    for (int i = 0; i < 4; ++i) *(u32x4*)(tpb + (i * 64 + lane) * 16) = tv[i];
  }
  for (int qd = bid * 8 + wid; qd < 8192; qd += nb * 8) {
    const int tokb = qd * 4;
    const int tok = tokb + grp;
    const float* mod = MOD + (tokb >> 13) * 6144;
    __syncthreads();
    for (int i = tid; i < 1024; i += NT) { GSl[i] = p.norm2_g[i] * (mod[4096 + i] + 1.0f); SHl[i] = mod[3072 + i]; G2l[i] = mod[5120 + i]; }
    __syncthreads();
    f32x2 suvv[16];
    {
      const int q = lane & 31, part = lane >> 5, jt = q >> 3, hd = q & 7, tk = tokb + jt;
      asm volatile("s_waitcnt lgkmcnt(0)" ::: "memory");
      const u32x4* tA = (const u32x4*)(tpb + (((tk - tokb) * 16 + hd * 2 + part) * 16) * 4);
      const u32x4* tB = (const u32x4*)(tpb + (((tk - tokb) * 16 + hd * 2 + (1 - part)) * 16) * 4);
      unsigned A[16], B[16];
#pragma unroll
      for (int i = 0; i < 4; ++i) { const u32x4 a = tA[i], bq = tB[i];
#pragma unroll
        for (int c = 0; c < 4; ++c) { A[4 * i + c] = a[c]; B[4 * i + c] = bq[c]; } }
      unsigned char* ib = (unsigned char*)(wbase + 6144);
      if (part == 0) {
#pragma unroll
        for (int i = 0; i < 4; ++i) {
          ((unsigned*)ib)[q * 8 + i] = (A[4 * i] & 127u) | ((A[4 * i + 1] & 127u) << 8) | ((A[4 * i + 2] & 127u) << 16) | ((A[4 * i + 3] & 127u) << 24);
          ((unsigned*)ib)[q * 8 + 4 + i] = (B[4 * i] & 127u) | ((B[4 * i + 1] & 127u) << 8) | ((B[4 * i + 2] & 127u) << 16) | ((B[4 * i + 3] & 127u) << 24);
        }
      }
      float va[4], vb[16];
#pragma unroll
      for (int k = 0; k < 4; ++k) va[k] = key2f(A[k] & ~127u);
#pragma unroll
      for (int k = 0; k < 16; ++k) vb[k] = key2f(B[k] & ~127u);
      unsigned Lb[2][16];
      {
        int n = 0;
#pragma unroll
        for (int a = 0; a < 4; ++a)
#pragma unroll
          for (int bb = a; bb < 16; ++bb) if ((a + 1) * (bb + 1) <= 16) {
            unsigned x = (f2key(va[a] + vb[bb]) & ~511u) | (unsigned)(part << 8) | (unsigned)(a << 4) | (unsigned)bb;
            if (a == bb) x = part ? 0u : x;
            Lb[n >> 4][n & 15] = x; ++n;
          }
#pragma unroll
        for (; n < 32; ++n) Lb[n >> 4][n & 15] = 0u;
      }
#pragma unroll
      for (int k = 2; k <= 16; k <<= 1)
#pragma unroll
        for (int j = k >> 1; j >= 1; j >>= 1)
#pragma unroll
          for (int i = 0; i < 16; ++i) if ((i & j) == 0) {
            const bool desc = (i & k) == 0;
#pragma unroll
            for (int c = 0; c < 2; ++c) {
              const unsigned a = Lb[c][i], b = Lb[c][i | j], mx = umax(a, b), mn = a < b ? a : b;
              Lb[c][i] = desc ? mx : mn; Lb[c][i | j] = desc ? mn : mx;
            }
          }
      unsigned Ls[16];
#pragma unroll
      for (int k = 0; k < 16; ++k) Ls[k] = umax(Lb[0][k], Lb[1][15 - k]);
#pragma unroll
      for (int d = 8; d >= 1; d >>= 1)
#pragma unroll
        for (int k = 0; k < 16; ++k) if ((k & d) == 0) { const unsigned a = Ls[k], c2 = Ls[k + d]; Ls[k] = umax(a, c2); Ls[k + d] = a < c2 ? a : c2; }
      unsigned C[16];
#pragma unroll
      for (int k = 0; k < 16; ++k) C[k] = umax(Ls[k], (unsigned)__shfl_xor((int)Ls[15 - k], 32));
#pragma unroll
      for (int d = 8; d >= 1; d >>= 1)
#pragma unroll
        for (int k = 0; k < 16; ++k) if ((k & d) == 0) { const unsigned a = C[k], c2 = C[k + d]; C[k] = umax(a, c2); C[k + d] = a < c2 ? a : c2; }
      float ex[16]; float den = 0.0f;
      const float smax = key2f(C[0] & ~511u);
#pragma unroll
      for (int k = 0; k < 16; ++k) { ex[k] = __expf(key2f(C[k] & ~511u) - smax); den += ex[k]; }
      const float rden = 1.0f / den;
      if (part == 0) {
#pragma unroll
        for (int k = 0; k < 16; ++k) {
          const unsigned c = C[k], pp = (c >> 8) & 1u, a = (c >> 4) & 15u, bb = c & 15u;
          const unsigned i1 = pp ? bb : a, i2 = pp ? a : bb;
          const unsigned ex_id = ((unsigned)ib[q * 32 + i1] * 128u + (unsigned)ib[q * 32 + 16 + i2]);
          const int slot = jt * 128 + hd * 16 + k;
          kl[slot] = (ex_id << 9) | (unsigned)slot;
          suvv[k] = SUV[ex_id];
          gl[slot] = ex[k] * rden;
        }
      }
    }
    h16x4 x1k[16];
#pragma unroll
    for (int i = 0; i < 4; ++i)
#pragma unroll
      for (int c = 0; c < 4; ++c) x1k[i * 4 + c] = *(const h16x4*)(X1 + (size_t)tok * 1024 + 256 * i + 64 * c + 4 * q16);
    const f32x4 sq = *(const f32x4*)(SSQ2 + (size_t)tok * 4);
    __builtin_amdgcn_sched_barrier(0);
    unsigned ks[8];
    {
      const u32x4 k0 = *(const u32x4*)(kl + grp * 128 + q16 * 8), k1 = *(const u32x4*)(kl + grp * 128 + q16 * 8 + 4);
#pragma unroll
      for (int c = 0; c < 4; ++c) { ks[c] = k0[c]; ks[4 + c] = k1[c]; }
    }
    bitonic_sort<128>(ks, q16);
    if ((lane >> 5) == 0) {
      const int q = lane & 31, slot0 = (q >> 3) * 128 + (q & 7) * 16;
#pragma unroll
      for (int k = 0; k < 16; ++k) { gl[slot0 + k] *= suvv[k][1]; sl[slot0 + k] = suvv[k][0]; }
    }
    int hq[16]; float sx;
    {
      const float rstd2 = rsqrtf(((sq[0] + sq[1]) + (sq[2] + sq[3])) * (1.0f / 1024.0f) + 1e-6f);
      f32x4 hv[16]; float am = 0.0f;
#pragma unroll
      for (int i = 0; i < 4; ++i) {
        __builtin_amdgcn_sched_barrier(0);
#pragma unroll
        for (int c = 0; c < 4; ++c) {
          const int el = 256 * i + 64 * c + 4 * q16;
          const h16x4 xh_ = x1k[i * 4 + c]; const f32x4 xv = {(float)xh_[0], (float)xh_[1], (float)xh_[2], (float)xh_[3]};
          const f32x4 gs = *(const f32x4*)(GSl + el), sh = *(const f32x4*)(SHl + el);
          const f32x4 h = xv * rstd2 * gs + sh;
          hv[i * 4 + c] = h;
          am = fmaxf(fmaxf(am, fmaxf(fabsf(h[0]), fabsf(h[1]))), fmaxf(fabsf(h[2]), fabsf(h[3])));
        }
      }
      __builtin_amdgcn_sched_barrier(0);
      { unsigned m = __float_as_uint(am); m = umax(m, dpp_u<0xB1>(m)); m = umax(m, dpp_u<0x4E>(m)); m = umax(m, dpp_u<0x141>(m)); m = umax(m, dpp_u<0x140>(m)); am = __uint_as_float(m); }
      const float qs = am > 0.0f ? 127.0f / am : 1.0f;
      sx = am * (1.0f / 127.0f);
#pragma unroll
      for (int k = 0; k < 16; ++k) {
        const int q0 = (int)rintf(hv[k][0] * qs), q1 = (int)rintf(hv[k][1] * qs), q2 = (int)rintf(hv[k][2] * qs), q3 = (int)rintf(hv[k][3] * qs);
        hq[k] = (int)((unsigned)(q0 & 255) | ((unsigned)(q1 & 255) << 8) | ((unsigned)(q2 & 255) << 16) | ((unsigned)(q3 & 255) << 24));
      }
    }
#define KEY_AT(RR, LL) ((unsigned)__shfl((int)ks[RR], (lane & 48) | (LL)))
#define U_LOAD(S, KEYV) { const unsigned key_ = (KEYV); \
      const unsigned char* ub_ = UB8 + (size_t)(key_ >> 9) * 1024 + q16 * 16; \
      _Pragma("unroll") for (int i = 0; i < 4; ++i) UR[S][i] = *(const u32x4*)(ub_ + 256 * i); \
      SUv[S] = sl[key_ & 511u]; GGv[S] = gl[key_ & 511u]; SLv[S] = key_ & 511u; }
#define U_COMPUTE(S) { \
      int a0_ = 0, a1_ = 0, a2_ = 0, a3_ = 0; \
      _Pragma("unroll") for (int i = 0; i < 4; ++i) { \
        a0_ = __builtin_amdgcn_sdot4((int)UR[S][i][0], hq[i * 4 + 0], a0_, false); a1_ = __builtin_amdgcn_sdot4((int)UR[S][i][1], hq[i * 4 + 1], a1_, false); \
        a2_ = __builtin_amdgcn_sdot4((int)UR[S][i][2], hq[i * 4 + 2], a2_, false); a3_ = __builtin_amdgcn_sdot4((int)UR[S][i][3], hq[i * 4 + 3], a3_, false); } \
      const float d = row_sum16((float)((a0_ + a1_) + (a2_ + a3_))) * (SUv[S] * sx); \
      const float w_ = GGv[S] * gelu_tanh_fast(d); \
      if (q16 == 0) gl[SLv[S]] = w_; }
    {
      u32x4 UR[4][4]; float SUv[4], GGv[4]; unsigned SLv[4];
      U_LOAD(0, KEY_AT(0, 0)) U_LOAD(1, KEY_AT(1, 0)) U_LOAD(2, KEY_AT(2, 0))
      unsigned keyn = KEY_AT(3, 0);
#pragma unroll 1
      for (int L = 0; L < 16; ++L) {
        const int Ln = L < 15 ? L + 1 : 15;
        if (!(L & 3)) __builtin_amdgcn_s_barrier();
#pragma unroll
        for (int r = 0; r < 8; ++r) {
          __builtin_amdgcn_sched_barrier(0);
          U_LOAD((r + 3) & 3, keyn)
          keyn = (r + 4 < 8) ? KEY_AT((r + 4) & 7, L) : KEY_AT((r + 4) & 7, Ln);
          __builtin_amdgcn_sched_barrier(0);
          U_COMPUTE(r & 3)
        }
      }
    }
#undef U_LOAD
#undef U_COMPUTE
    u32x4 tvn[4];
    {
      const int qn = qd + nb * 8;
      const u32x4* tsrc = (const u32x4*)(TOPK + (size_t)(qn < 8192 ? qn : qd) * 4 * 256) + lane;
#pragma unroll
      for (int i = 0; i < 4; ++i) tvn[i] = tsrc[i * 64];
    }
    __builtin_amdgcn_sched_barrier(0);
    f32x2 acc[32];
#pragma unroll
    for (int i = 0; i < 32; ++i) acc[i] = (f32x2){0.0f, 0.0f};
#define V_LOAD(S, KEYV) { const unsigned key_ = (KEYV); \
      const unsigned char* vb_ = VB8 + (size_t)(key_ >> 9) * 512 + q16 * 16; \
      VR[S][0] = *(const u32x4*)(vb_); VR[S][1] = *(const u32x4*)(vb_ + 256); \
      WWv[S] = gl[key_ & 511u]; }
#define V_COMPUTE(S) { const f32x2 w2 = {WWv[S], WWv[S]}; \
      _Pragma("unroll") for (int w = 0; w < 8; ++w) { \
        const unsigned vw_ = VR[S][w >> 2][w & 3]; \
        acc[4 * w + 0] = __builtin_elementwise_fma(w2, __builtin_amdgcn_cvt_scalef32_pk_f32_fp4(vw_, 1.0f, 0), acc[4 * w + 0]); \
        acc[4 * w + 1] = __builtin_elementwise_fma(w2, __builtin_amdgcn_cvt_scalef32_pk_f32_fp4(vw_, 1.0f, 1), acc[4 * w + 1]); \
        acc[4 * w + 2] = __builtin_elementwise_fma(w2, __builtin_amdgcn_cvt_scalef32_pk_f32_fp4(vw_, 1.0f, 2), acc[4 * w + 2]); \
        acc[4 * w + 3] = __builtin_elementwise_fma(w2, __builtin_amdgcn_cvt_scalef32_pk_f32_fp4(vw_, 1.0f, 3), acc[4 * w + 3]); } }
    {
      u32x4 VR[4][2]; float WWv[4];
      V_LOAD(0, KEY_AT(0, 0)) V_LOAD(1, KEY_AT(1, 0)) V_LOAD(2, KEY_AT(2, 0))
      __builtin_amdgcn_sched_barrier(0);
#pragma unroll
      for (int i = 0; i < 4; ++i) *(u32x4*)(tpb + (i * 64 + lane) * 16) = tvn[i];
      __builtin_amdgcn_sched_barrier(0);
      unsigned keyn = KEY_AT(3, 0);
#pragma unroll 1
      for (int L = 0; L < 16; ++L) {
        const int Ln = L < 15 ? L + 1 : 15;
        if (!(L & 7)) __builtin_amdgcn_s_barrier();
#pragma unroll
        for (int r = 0; r < 8; ++r) {
          __builtin_amdgcn_sched_barrier(0);
          V_LOAD((r + 3) & 3, keyn)
          keyn = (r + 4 < 8) ? KEY_AT((r + 4) & 7, L) : KEY_AT((r + 4) & 7, Ln);
          __builtin_amdgcn_sched_barrier(0);
          V_COMPUTE(r & 3)
        }
      }
    }
#undef V_LOAD
#undef V_COMPUTE
#undef KEY_AT
    {
      f32x4 x2[16]; float ss = 0.0f;
#pragma unroll
      for (int i = 0; i < 4; ++i) {
        __builtin_amdgcn_sched_barrier(0);
#pragma unroll
        for (int c = 0; c < 4; ++c) {
          const int el = 256 * i + 64 * c + 4 * q16;
          const h16x4 xh_ = x1k[i * 4 + c]; const f32x4 xv = {(float)xh_[0], (float)xh_[1], (float)xh_[2], (float)xh_[3]};
          const f32x4 g2 = *(const f32x4*)(G2l + el);
          const f32x4 pr = {acc[i * 8 + c * 2][0], acc[i * 8 + c * 2][1], acc[i * 8 + c * 2 + 1][0], acc[i * 8 + c * 2 + 1][1]};
          const f32x4 v = xv + g2 * pr;
          x2[i * 4 + c] = v;
          ss += (v[0] * v[0] + v[1] * v[1]) + (v[2] * v[2] + v[3] * v[3]);
        }
      }
      __builtin_amdgcn_sched_barrier(0);
      ss = row_sum16(ss);
      const float rstd = rsqrtf(ss * (1.0f / 1024.0f) + 1e-6f);
#pragma unroll
      for (int i = 0; i < 4; ++i)
#pragma unroll
        for (int c = 0; c < 4; ++c) {
          const int el = 256 * i + 64 * c + 4 * q16;
          *(f32x4*)(outp + (size_t)tok * 1024 + el) = x2[i * 4 + c] * rstd * *(const f32x4*)(FNl + el);
        }
    }
  }
}


__global__ void __launch_bounds__(NT) fwd_megakernel(Params p) {
  extern __shared__ __attribute__((aligned(16))) char shm[];
  cg::grid_group grid = cg::this_grid();
  const int bid = blockIdx.x, nb = gridDim.x;
  volatile LAS unsigned* xst = (volatile LAS unsigned*)(shm + LDS_USED);
  if (threadIdx.x < 4) xst[threadIdx.x] = 0u;
  __syncthreads();
  const XcdBarrier xb = xcd_barrier_post((unsigned*)(p.ws + OFF_BAR), xst);
#define GSYNC() xcd_barrier(xb)
  if (p.ws == nullptr) grid.sync();
  phase0a(p, shm, bid, nb); GSYNC();
  phase0b(p, shm, bid, nb); GSYNC();
  phase1(p, shm, bid, nb);  GSYNC();
  phase1b(p, shm, bid, nb); GSYNC();
  phase2(p, shm, bid, nb);  GSYNC();
  phase3a(p, shm, bid, nb); GSYNC();
  phase3b(p, shm, bid, nb); GSYNC();
  phase3c(p, shm, bid, nb); GSYNC();
  phase3d(p, shm, bid, nb, p.out);
}

extern "C" void kernel_launch(void* const* d_in, const int* in_sizes, int n_in, void* d_out, int out_size, void* d_ws, size_t ws_size, hipStream_t stream) {
  if (ws_size < WS_NEED) { fprintf(stderr, "workspace too small: %zu < %zu\n", ws_size, (size_t)WS_NEED); return; }
  Params p{};
  const float** pp = (const float**)&p;
  for (int i = 0; i < 24; ++i) pp[i] = (const float*)d_in[i];
  p.out = (float*)d_out; p.ws = (char*)d_ws;
  static int grid_blocks = 0;
  if (!grid_blocks) {
    hipFuncSetAttribute((const void*)fwd_megakernel, hipFuncAttributeMaxDynamicSharedMemorySize, LDS_BYTES);
    int dev = 0, cus = 0, per_cu = 0;
    hipGetDevice(&dev);
    hipDeviceGetAttribute(&cus, hipDeviceAttributeMultiprocessorCount, dev);
    hipOccupancyMaxActiveBlocksPerMultiprocessor(&per_cu, fwd_megakernel, NT, LDS_BYTES);
    if (per_cu > 1) per_cu = 1;
    grid_blocks = cus * per_cu;
  }
  (void)hipMemsetAsync((char*)d_ws + OFF_BAR, 0, 16384, stream);
  void* args[] = {&p};
  hipError_t e = hipLaunchCooperativeKernel((void*)fwd_megakernel, dim3(grid_blocks), dim3(NT), args, LDS_BYTES, stream);
  if (e != hipSuccess) fprintf(stderr, "cooperative launch failed: %s (grid %d)\n", hipGetErrorString(e), grid_blocks);
}
```
